# Optimizing an MI355X kernel written in HIP

```python
import math
import jax, jax.numpy as jnp
from jax import lax
import numpy as np

D_MODEL = 1024
BATCH = 4
SEQ = 8192
DEPTH = 4

GRID_W = 64
CTX_LEN = 256
N_MIXERS = 3
N_MOD = 6
NORM_EPS = 1e-6
NEG_INF = -1e30
A_HEADS = 16
A_KV_HEADS = 4
A_HEAD_DIM = D_MODEL // A_HEADS
A_WINDOW = 128
A_BLOCK = 128
ROPE_BASE = 10000.0
M_HEADS = 4
M_V_DIM = D_MODEL // M_HEADS
M_QK_DIM = M_V_DIM // 2
M_CHUNK = 64
C_HEADS = 16
C_HEAD_DIM = D_MODEL // C_HEADS
NA_WIN_R = 8
NA_WIN_C = 16
N_EXPERTS = 32
TOP_K = 4
D_FF = D_MODEL
SWIGLU_LIMIT = 7.0
SWIGLU_ALPHA = 1.702
MOE_BLOCK = 512
N_LAYERS_A = (DEPTH + N_MIXERS - 1) // N_MIXERS
N_LAYERS_B = (DEPTH + N_MIXERS - 2) // N_MIXERS
N_LAYERS_C = DEPTH // N_MIXERS

kernel_name = 'hybrid_dit_swa_mlstm_natten_moe'

F32 = jnp.float32


def rms_norm(x, g):
    x32 = x.astype(F32)
    y = x32 * lax.rsqrt(jnp.mean(x32 * x32, axis=-1, keepdims=True) + NORM_EPS)
    return (y * g.astype(F32)).astype(x.dtype)


def modulate(h, shift, scale):
    return h * (1 + scale) + shift


def axial_rope(t, rows, cols):
    d = t.shape[-1]
    half = d // 2
    quarter = half // 2
    freqs = ROPE_BASE ** (-jnp.arange(quarter, dtype=F32) / quarter)

    def rot(u, pos):
        ang = pos.astype(F32)[:, None] * freqs[None, :]
        cos = jnp.cos(ang)[None, :, None, :]
        sin = jnp.sin(ang)[None, :, None, :]
        u1 = u[..., :quarter].astype(F32)
        u2 = u[..., quarter:].astype(F32)
        return jnp.concatenate([u1 * cos - u2 * sin, u1 * sin + u2 * cos], axis=-1)

    out = jnp.concatenate([rot(t[..., :half], rows), rot(t[..., half:], cols)], axis=-1)
    return out.astype(t.dtype)


def window_gqa(hl, hc, wqkv, wo, sink, rows, cols, need_ctx):
    B, S, _ = hl.shape
    Lc = hc.shape[1]
    G = A_HEADS // A_KV_HEADS
    qw = A_HEADS * A_HEAD_DIM
    kw = A_KV_HEADS * A_HEAD_DIM
    scale = A_HEAD_DIM ** -0.5
    sink_g = sink.astype(F32).reshape(A_KV_HEADS, G)

    def q_proj(h):
        return (h @ wqkv[:, :qw]).reshape(B, h.shape[1], A_HEADS, A_HEAD_DIM)

    def kv_proj(h):
        p = h @ wqkv[:, qw:]
        L = h.shape[1]
        return (p[..., :kw].reshape(B, L, A_KV_HEADS, A_HEAD_DIM),
                p[..., kw:].reshape(B, L, A_KV_HEADS, A_HEAD_DIM))

    ql = axial_rope(q_proj(hl), rows, cols).reshape(B, S, A_KV_HEADS, G, A_HEAD_DIM)
    kl, vl = kv_proj(hl)
    kl = axial_rope(kl, rows, cols)
    kc, vc = kv_proj(hc)
    pad = ((0, 0), (A_BLOCK, A_BLOCK), (0, 0), (0, 0))
    kp = jnp.pad(kl, pad)
    vp = jnp.pad(vl, pad)
    n_blocks = S // A_BLOCK
    qoffs = jnp.arange(A_BLOCK)
    koffs = jnp.arange(3 * A_BLOCK) - A_BLOCK
    band = jnp.abs(koffs[None, :] - qoffs[:, None]) <= A_WINDOW

    def block(i):
        start = i * A_BLOCK
        qb = lax.dynamic_slice_in_dim(ql, start, A_BLOCK, axis=1)
        kb = lax.dynamic_slice_in_dim(kp, start, 3 * A_BLOCK, axis=1)
        vb = lax.dynamic_slice_in_dim(vp, start, 3 * A_BLOCK, axis=1)
        kpos = start + koffs
        valid = band & ((kpos >= 0) & (kpos < S))[None, :]
        s_loc = jnp.einsum('bqhgd,bkhd->bhgqk', qb, kb, preferred_element_type=F32) * scale
        s_loc = jnp.where(valid, s_loc, NEG_INF)
        s_ctx = jnp.einsum('bqhgd,bchd->bhgqc', qb, kc, preferred_element_type=F32) * scale
        s_sink = jnp.broadcast_to(sink_g[None, :, :, None, None], (B, A_KV_HEADS, G, A_BLOCK, 1))
        p = jax.nn.softmax(jnp.concatenate([s_sink, s_ctx, s_loc], axis=-1), axis=-1).astype(vl.dtype)
        return (jnp.einsum('bhgqc,bchd->bqhgd', p[..., 1:1 + Lc], vc)
                + jnp.einsum('bhgqk,bkhd->bqhgd', p[..., 1 + Lc:], vb))

    ol = lax.map(block, jnp.arange(n_blocks))
    yl = jnp.moveaxis(ol, 0, 1).reshape(B, S, qw) @ wo
    if not need_ctx:
        return yl, None
    qc = q_proj(hc).reshape(B, Lc, A_KV_HEADS, G, A_HEAD_DIM)
    s = jnp.einsum('bqhgd,bchd->bhgqc', qc, kc, preferred_element_type=F32) * scale
    s_sink = jnp.broadcast_to(sink_g[None, :, :, None, None], (B, A_KV_HEADS, G, Lc, 1))
    p = jax.nn.softmax(jnp.concatenate([s_sink, s], axis=-1), axis=-1).astype(vc.dtype)
    yc = jnp.einsum('bhgqc,bchd->bqhgd', p[..., 1:], vc).reshape(B, Lc, qw) @ wo
    return yl, yc


def mlstm_scan(q, k, v, ig, lf, state):
    B, H, L, _ = q.shape
    dv = v.shape[-1]
    nc = L // M_CHUNK

    def chunks(t):
        return jnp.moveaxis(t.reshape((B, H, nc, M_CHUNK) + t.shape[3:]), 2, 0)

    tril = jnp.tril(jnp.ones((M_CHUNK, M_CHUNK), dtype=bool))

    def step(carry, xs):
        C, n, m = carry
        qc, kc, vc, ic, fc = xs
        qf = qc.astype(F32)
        kf = kc.astype(F32)
        vf = vc.astype(F32)
        b = jnp.cumsum(fc, axis=-1)
        log_d = jnp.where(tril, b[..., :, None] - b[..., None, :] + ic[..., None, :], NEG_INF)
        m_inter = b + m[..., None]
        m_t = jnp.maximum(jnp.max(log_d, axis=-1), m_inter)
        d_mat = jnp.exp(log_d - m_t[..., None])
        inter = jnp.exp(m_inter - m_t)
        s = jnp.einsum('bhtd,bhsd->bhts', qf, kf) * d_mat
        num = jnp.einsum('bhts,bhsv->bhtv', s, vf) + inter[..., None] * jnp.einsum('bhvd,bhtd->bhtv', C, qf)
        den = jnp.sum(s, axis=-1) + inter * jnp.einsum('bhd,bhtd->bht', n, qf)
        h = num / jnp.maximum(jnp.abs(den), jnp.exp(-m_t))[..., None]
        b_last = b[..., -1]
        log_w = b_last[..., None] - b + ic
        m_new = jnp.maximum(b_last + m, jnp.max(log_w, axis=-1))
        w = jnp.exp(log_w - m_new[..., None])
        decay = jnp.exp(b_last + m - m_new)
        C_new = decay[..., None, None] * C + jnp.einsum('bhs,bhsv,bhsd->bhvd', w, vf, kf)
        n_new = decay[..., None] * n + jnp.einsum('bhs,bhsd->bhd', w, kf)
        return (C_new, n_new, m_new), h

    state, hs = lax.scan(step, state, (chunks(q), chunks(k), chunks(v), chunks(ig), chunks(lf)))
    return jnp.moveaxis(hs, 0, 2).reshape(B, H, L, dv), state


def mlstm_mixer(hl, hc, w_in, b_gate, hnorm_g, wo, need_ctx):
    B = hl.shape[0]
    qk = M_HEADS * M_QK_DIM
    vw = M_HEADS * M_V_DIM

    def proj(h):
        L = h.shape[1]
        p = h @ w_in

        def heads(t, d):
            return t.reshape(B, L, M_HEADS, d).transpose(0, 2, 1, 3)

        q = heads(p[..., :qk], M_QK_DIM)
        k = heads(p[..., qk:2 * qk], M_QK_DIM) * (M_QK_DIM ** -0.5)
        v = heads(p[..., 2 * qk:2 * qk + vw], M_V_DIM)
        o = p[..., 2 * qk + vw:2 * qk + 2 * vw]
        g = (p[..., 2 * qk + 2 * vw:].astype(F32) + b_gate.astype(F32))
        g = g.reshape(B, L, 4, M_HEADS).transpose(2, 0, 3, 1)
        return q, k, v, o, g

    def flip(t):
        return jnp.flip(t, axis=2)

    def run(q, k, v, g, st_f, st_b):
        hf, sf = mlstm_scan(q, k, v, g[0], jax.nn.log_sigmoid(g[1]), st_f)
        hb, sb = mlstm_scan(flip(q), flip(k), flip(v), flip(g[2]), jax.nn.log_sigmoid(flip(g[3])), st_b)
        return hf + flip(hb), sf, sb

    def readout(h, o):
        L = h.shape[2]
        h = h.transpose(0, 2, 1, 3)
        h = h * lax.rsqrt(jnp.mean(h * h, axis=-1, keepdims=True) + NORM_EPS)
        h = h.reshape(B, L, vw) * hnorm_g.astype(F32) * jax.nn.sigmoid(o.astype(F32))
        return h.astype(o.dtype) @ wo

    init = (jnp.zeros((B, M_HEADS, M_V_DIM, M_QK_DIM), F32),
            jnp.zeros((B, M_HEADS, M_QK_DIM), F32),
            jnp.full((B, M_HEADS), NEG_INF, F32))
    qc, kc, vc, oc, gc = proj(hc)
    h_ctx, st_f, st_b = run(qc, kc, vc, gc, init, init)
    ql, kl, vl, ol, gl = proj(hl)
    h_lat, _, _ = run(ql, kl, vl, gl, st_f, st_b)
    yl = readout(h_lat, ol)
    yc = readout(h_ctx, oc) if need_ctx else None
    return yl, yc


def neighborhood_attn(hl, hc, wqkv, wo, rpb, need_ctx):
    B, S, _ = hl.shape
    Lc = hc.shape[1]
    R = S // GRID_W
    WR = min(NA_WIN_R, R)
    hw = C_HEADS * C_HEAD_DIM
    scale = C_HEAD_DIM ** -0.5
    p = hl @ wqkv
    q = p[..., :hw].reshape(B, R, GRID_W, C_HEADS, C_HEAD_DIM)
    k = p[..., hw:2 * hw].reshape(B, R, GRID_W, C_HEADS, C_HEAD_DIM)
    v = p[..., 2 * hw:].reshape(B, R, GRID_W, C_HEADS, C_HEAD_DIM)
    pc = hc @ wqkv[:, hw:]
    kc = pc[..., :hw].reshape(B, Lc, C_HEADS, C_HEAD_DIM)
    vc = pc[..., hw:].reshape(B, Lc, C_HEADS, C_HEAD_DIM)
    n_keys = WR * GRID_W
    qcol = jnp.arange(GRID_W)
    kcol = jnp.tile(jnp.arange(GRID_W), WR)
    krow = jnp.repeat(jnp.arange(WR), GRID_W)
    cstart = jnp.clip(qcol - NA_WIN_C // 2, 0, GRID_W - NA_WIN_C)
    col_in = (kcol[None, :] >= cstart[:, None]) & (kcol[None, :] < cstart[:, None] + NA_WIN_C)
    dc_idx = jnp.clip(kcol[None, :] - qcol[:, None] + NA_WIN_C - 1, 0, 2 * NA_WIN_C - 2)
    rpb32 = rpb.astype(F32)

    def row(r):
        rs = jnp.clip(r - WR // 2, 0, R - WR)
        qr = lax.dynamic_index_in_dim(q, r, axis=1, keepdims=False)
        kb = lax.dynamic_slice_in_dim(k, rs, WR, axis=1).reshape(B, n_keys, C_HEADS, C_HEAD_DIM)
        vb = lax.dynamic_slice_in_dim(v, rs, WR, axis=1).reshape(B, n_keys, C_HEADS, C_HEAD_DIM)
        dr_idx = rs + krow - r + NA_WIN_R - 1
        bias = rpb32[:, dr_idx[None, :], dc_idx]
        s_loc = jnp.einsum('bqhd,bkhd->bhqk', qr, kb, preferred_element_type=F32) * scale + bias
        s_loc = jnp.where(col_in, s_loc, NEG_INF)
        s_ctx = jnp.einsum('bqhd,bchd->bhqc', qr, kc, preferred_element_type=F32) * scale
        pr = jax.nn.softmax(jnp.concatenate([s_ctx, s_loc], axis=-1), axis=-1).astype(v.dtype)
        return (jnp.einsum('bhqc,bchd->bqhd', pr[..., :Lc], vc)
                + jnp.einsum('bhqk,bkhd->bqhd', pr[..., Lc:], vb))

    ol = lax.map(row, jnp.arange(R))
    yl = jnp.moveaxis(ol, 0, 1).reshape(B, S, hw) @ wo
    if not need_ctx:
        return yl, None
    qc = (hc @ wqkv[:, :hw]).reshape(B, Lc, C_HEADS, C_HEAD_DIM)
    s = jnp.einsum('bqhd,bchd->bhqc', qc, kc, preferred_element_type=F32) * scale
    pc_ = jax.nn.softmax(s, axis=-1).astype(vc.dtype)
    yc = jnp.einsum('bhqc,bchd->bqhd', pc_, vc).reshape(B, Lc, hw) @ wo
    return yl, yc


def moe_ffn(xt, router_w, router_b, w_in, b_in, w_out, b_out):
    T, D = xt.shape
    logits = jnp.dot(xt, router_w, preferred_element_type=F32) + router_b.astype(F32)
    top_val, top_idx = lax.top_k(logits, TOP_K)
    gates = jax.nn.softmax(top_val, axis=-1)
    e_flat = top_idx.reshape(-1).astype(jnp.int32)
    tok_flat = jnp.repeat(jnp.arange(T, dtype=jnp.int32), TOP_K)
    g_flat = gates.reshape(-1)
    order = jnp.argsort(e_flat)
    e_sorted = e_flat[order]
    counts = jnp.bincount(e_flat, length=N_EXPERTS)
    starts = jnp.cumsum(counts) - counts
    padded = (counts + MOE_BLOCK - 1) // MOE_BLOCK * MOE_BLOCK
    pad_ends = jnp.cumsum(padded)
    pad_starts = pad_ends - padded
    n_assign = T * TOP_K
    dest = pad_starts[e_sorted] + jnp.arange(n_assign, dtype=jnp.int32) - starts[e_sorted]
    n_blocks = -(-n_assign // MOE_BLOCK) + N_EXPERTS
    n_rows = n_blocks * MOE_BLOCK
    src_tok = jnp.full((n_rows,), T, jnp.int32).at[dest].set(tok_flat[order])
    row_gate = jnp.zeros((n_rows,), F32).at[dest].set(g_flat[order])
    x_pad = jnp.concatenate([xt, jnp.zeros((1, D), xt.dtype)], axis=0)
    xb = x_pad[src_tok].reshape(n_blocks, MOE_BLOCK, D)
    block_expert = jnp.minimum(
        jnp.searchsorted(pad_ends, jnp.arange(n_blocks) * MOE_BLOCK, side='right'), N_EXPERTS - 1)

    def expert_block(args):
        xe, e = args
        hcat = xe @ w_in[e] + b_in[e]
        gate = jnp.minimum(hcat[:, ::2], SWIGLU_LIMIT)
        up = jnp.clip(hcat[:, 1::2], -SWIGLU_LIMIT, SWIGLU_LIMIT)
        glu = gate * jax.nn.sigmoid(SWIGLU_ALPHA * gate)
        return ((up + 1) * glu) @ w_out[e] + b_out[e]

    yb = lax.map(expert_block, (xb, block_expert)).reshape(n_rows, D)
    y = jax.ops.segment_sum(yb.astype(F32) * row_gate[:, None], src_tok, num_segments=T + 1)[:T]
    return y.astype(xt.dtype)


def setup_inputs(seed: int = 0) -> dict:
    key = jax.random.key(seed)
    ks = jax.random.split(key, 32)

    def nrm(k, shape, s):
        return jax.random.normal(k, shape, F32) * s

    D = D_MODEL
    a_qkv_w = (A_HEADS + 2 * A_KV_HEADS) * A_HEAD_DIM
    m_in_w = 2 * M_HEADS * M_QK_DIM + 2 * M_HEADS * M_V_DIM + 4 * M_HEADS
    c_qkv_w = 3 * C_HEADS * C_HEAD_DIM
    fg_base = jnp.linspace(3.0, 6.0, M_HEADS, dtype=F32)[None, :]
    m_bgate = jnp.concatenate([
        nrm(ks[10], (N_LAYERS_B, M_HEADS), 0.1),
        fg_base + nrm(ks[11], (N_LAYERS_B, M_HEADS), 0.1),
        nrm(ks[12], (N_LAYERS_B, M_HEADS), 0.1),
        fg_base + nrm(ks[13], (N_LAYERS_B, M_HEADS), 0.1)], axis=-1)
    return {
        'x': nrm(ks[0], (BATCH, SEQ, D), 1.0),
        'c': nrm(ks[1], (BATCH, D), 1.0),
        'ctx': nrm(ks[2], (BATCH, CTX_LEN, D), 1.0),
        'c_ctx': nrm(ks[3], (D,), 1.0),
        'ada_w': nrm(ks[4], (DEPTH, D, N_MOD * D), 0.5 * D ** -0.5),
        'ada_b': nrm(ks[5], (DEPTH, N_MOD * D), 0.02),
        'norm1_g': 1.0 + nrm(ks[6], (DEPTH, D), 0.02),
        'norm2_g': 1.0 + nrm(ks[7], (DEPTH, D), 0.02),
        'a_wqkv': nrm(ks[8], (N_LAYERS_A, D, a_qkv_w), D ** -0.5),
        'a_wo': nrm(ks[9], (N_LAYERS_A, A_HEADS * A_HEAD_DIM, D), (A_HEADS * A_HEAD_DIM) ** -0.5),
        'a_sink': nrm(ks[14], (N_LAYERS_A, A_HEADS), 0.5),
        'm_win': nrm(ks[15], (N_LAYERS_B, D, m_in_w), D ** -0.5),
        'm_bgate': m_bgate,
        'm_hnorm': 1.0 + nrm(ks[16], (N_LAYERS_B, M_HEADS * M_V_DIM), 0.02),
        'm_wo': nrm(ks[17], (N_LAYERS_B, M_HEADS * M_V_DIM, D), (M_HEADS * M_V_DIM) ** -0.5),
        'n_wqkv': nrm(ks[18], (N_LAYERS_C, D, c_qkv_w), D ** -0.5),
        'n_wo': nrm(ks[19], (N_LAYERS_C, C_HEADS * C_HEAD_DIM, D), (C_HEADS * C_HEAD_DIM) ** -0.5),
        'n_rpb': nrm(ks[20], (N_LAYERS_C, C_HEADS, 2 * NA_WIN_R - 1, 2 * NA_WIN_C - 1), 0.1),
        'router_w': nrm(ks[21], (DEPTH, D, N_EXPERTS), D ** -0.5),
        'router_b': nrm(ks[22], (DEPTH, N_EXPERTS), 0.01),
        'exp_w_in': nrm(ks[23], (DEPTH, N_EXPERTS, D, 2 * D_FF), D ** -0.5),
        'exp_b_in': nrm(ks[24], (DEPTH, N_EXPERTS, 2 * D_FF), 0.01),
        'exp_w_out': nrm(ks[25], (DEPTH, N_EXPERTS, D_FF, D), D_FF ** -0.5),
        'exp_b_out': nrm(ks[26], (DEPTH, N_EXPERTS, D), 0.01),
        'final_g': 1.0 + nrm(ks[27], (D,), 0.02),
    }


def reference(x, c, ctx, c_ctx, ada_w, ada_b, norm1_g, norm2_g, a_wqkv, a_wo, a_sink,
              m_win, m_bgate, m_hnorm, m_wo, n_wqkv, n_wo, n_rpb,
              router_w, router_b, exp_w_in, exp_b_in, exp_w_out, exp_b_out, final_g):
    B, S, D = x.shape
    Lc = ctx.shape[1]
    pos = jnp.arange(S, dtype=jnp.int32)
    rows = pos // GRID_W
    cols = pos % GRID_W
    s_c = jax.nn.silu(c)
    s_cc = jax.nn.silu(c_ctx)
    for layer in range(DEPTH):
        last = layer == DEPTH - 1
        kind = layer % N_MIXERS
        j = layer // N_MIXERS
        m_l = (s_c @ ada_w[layer] + ada_b[layer]).reshape(B, 1, N_MOD, D)
        m_c = (s_cc @ ada_w[layer] + ada_b[layer]).reshape(1, 1, N_MOD, D)
        hl = modulate(rms_norm(x, norm1_g[layer]), m_l[:, :, 0], m_l[:, :, 1])
        hc = modulate(rms_norm(ctx, norm1_g[layer]), m_c[:, :, 0], m_c[:, :, 1])
        if kind == 0:
            yl, yc = window_gqa(hl, hc, a_wqkv[j], a_wo[j], a_sink[j], rows, cols, not last)
        elif kind == 1:
            yl, yc = mlstm_mixer(hl, hc, m_win[j], m_bgate[j], m_hnorm[j], m_wo[j], not last)
        else:
            yl, yc = neighborhood_attn(hl, hc, n_wqkv[j], n_wo[j], n_rpb[j], not last)
        x = x + m_l[:, :, 2] * yl
        h2l = modulate(rms_norm(x, norm2_g[layer]), m_l[:, :, 3], m_l[:, :, 4])
        if last:
            y = moe_ffn(h2l.reshape(B * S, D), router_w[layer], router_b[layer],
                        exp_w_in[layer], exp_b_in[layer], exp_w_out[layer], exp_b_out[layer])
            x = x + m_l[:, :, 5] * y.reshape(B, S, D)
        else:
            ctx = ctx + m_c[:, :, 2] * yc
            h2c = modulate(rms_norm(ctx, norm2_g[layer]), m_c[:, :, 3], m_c[:, :, 4])
            tokens = jnp.concatenate([h2l.reshape(B * S, D), h2c.reshape(B * Lc, D)], axis=0)
            y = moe_ffn(tokens, router_w[layer], router_b[layer],
                        exp_w_in[layer], exp_b_in[layer], exp_w_out[layer], exp_b_out[layer])
            x = x + m_l[:, :, 5] * y[:B * S].reshape(B, S, D)
            ctx = ctx + m_c[:, :, 5] * y[B * S:].reshape(B, Lc, D)
    return rms_norm(x, final_g)
```

```cpp
#include <hip/hip_runtime.h>
#include <cstdio>
#include <cstdint>

#define GAS __attribute__((address_space(1)))
#define LAS __attribute__((address_space(3)))
typedef unsigned short bf16;
typedef float f32x4 __attribute__((ext_vector_type(4)));
typedef float f32x2 __attribute__((ext_vector_type(2)));
typedef unsigned v4u __attribute__((ext_vector_type(4)));
typedef unsigned v2u __attribute__((ext_vector_type(2)));
typedef short bf16x8 __attribute__((ext_vector_type(8)));
typedef int v8i __attribute__((ext_vector_type(8)));
typedef int v4i __attribute__((ext_vector_type(4)));

constexpr int D = 1024, NB = 4, SEQ = 8192, LC = 256, NEXP = 32, DFF = 1024;
constexpr int T_LAT = NB * SEQ, T_CTX = NB * LC, T_ALL = T_LAT + T_CTX;
constexpr float EPS = 1e-6f;
constexpr int NTHREADS = 512, NWAVES = 8;
#ifndef QKV_F8_A
#define QKV_F8_A 1
#endif
#ifndef QKV_F8_M
#define QKV_F8_M 1
#endif
#ifndef QKV_F8_N
#define QKV_F8_N 1
#endif
#ifndef WO_F8
#define WO_F8 1
#endif
#define YS_F8 1
constexpr float F8_YS = 16.f;
constexpr float F8_DS = 32.f;
constexpr float F8_W1S = 32.f, F8_HS = 32.f, F8_W2S = 8.f, F8_AS = 8.f;
constexpr int F8_S1 = 0x7a7a7a7a, F8_S2 = 0x7c7c7c7c;
constexpr int NT_MAX = (4 * T_ALL) / 256 + NEXP;

enum { I_X = 0, I_C, I_CTX, I_CCTX, I_ADAW, I_ADAB, I_N1G, I_N2G, I_AWQKV, I_AWO, I_ASINK, I_MWIN, I_MBG, I_MHN, I_MWO, I_NWQKV, I_NWO, I_NRPB,
       I_RW, I_RB, I_EWIN, I_EBIN, I_EWOUT, I_EBOUT, I_FG };

constexpr size_t MiB = 1u << 20;
constexpr size_t WS_CTL = 0, CTL_BYTES = 1 * MiB;
constexpr size_t WS_MOD = 1 * MiB;
constexpr size_t WS_GWT = 1 * MiB + 768 * 1024;
constexpr size_t WS_RWT = 2 * MiB;
constexpr size_t WS_AWQKV = 4 * MiB;
constexpr size_t WS_AWO = WS_AWQKV + 6 * MiB;
constexpr size_t WS_MWIN = WS_AWO + 4 * MiB;
constexpr size_t WS_MWO = WS_MWIN + 6 * MiB;
constexpr size_t WS_NWQKV = WS_MWO + 2 * MiB;
constexpr size_t WS_NWO = WS_NWQKV + 6 * MiB;
constexpr size_t WS_EWIN = 32 * MiB;
constexpr size_t WS_EWOUT = WS_EWIN + 512 * MiB;
constexpr size_t WS_X = WS_EWOUT + 256 * MiB;
constexpr size_t WS_H = WS_X + 132 * MiB;
constexpr size_t WS_QKV = WS_H + 66 * MiB;
constexpr size_t WS_O = WS_QKV + 198 * MiB;
constexpr size_t WS_ACT = WS_O + 66 * MiB;
constexpr size_t WS_YS = WS_ACT + 280 * MiB;
constexpr size_t WS_SLOT = WS_YS + 264 * MiB;
constexpr size_t WS_GATE = WS_SLOT + 5 * MiB;
constexpr size_t WS_GB = WS_GATE + 5 * MiB;
constexpr size_t WS_HD = WS_GB + 3 * MiB;
constexpr size_t WS_H8 = WS_HD + 264 * MiB;
constexpr size_t WS_END = WS_H8 + 33 * MiB;
constexpr int CW_BAR = 4096;
constexpr int CW_CNT = 16384;

constexpr int LDS_BYTES = 147456;
constexpr int MISC_OFF = 131072;

#define XB_TMO      128
#define XB_XCNT(j)  (256  + 64 * (j))
#define XB_XSUB(j)  (1280 + 64 * (j))
#define XB_XGEN(j)  (2304 + 64 * (j))
#define XB_TOP      3328
#define XB_TOPGEN   3392
#define XCD_BAR_WORDS 3456
#define XB_SPIN_CAP (1u << 22)
__device__ __forceinline__ unsigned xb_ld(unsigned* p)              { return __hip_atomic_load(p, __ATOMIC_RELAXED, __HIP_MEMORY_SCOPE_AGENT); }
__device__ __forceinline__ unsigned xb_add(unsigned* p, unsigned v) { return __hip_atomic_fetch_add(p, v, __ATOMIC_RELAXED, __HIP_MEMORY_SCOPE_AGENT); }
__device__ __forceinline__ unsigned xb_xcc_id() { return (unsigned)__builtin_amdgcn_s_getreg((3 << 11) | 20) & 0xFu; }
#define XB_SPIN(cond, bar) do { unsigned _sp = 0; while (cond) { __builtin_amdgcn_s_sleep(1); \
    if ((++_sp & 255u) == 0u) { if (xb_ld(&(bar)[XB_TMO])) break; if (_sp > XB_SPIN_CAP) { atomicAdd(&(bar)[XB_TMO], 1u); break; } } } } while (0)
struct XcdBarrier { unsigned* bar; unsigned x; volatile LAS unsigned* st; };
__device__ __forceinline__ XcdBarrier xcd_barrier_post(unsigned* bar, volatile LAS unsigned* st) {
    XcdBarrier b; b.bar = bar; b.x = xb_xcc_id(); b.st = st;
    if (threadIdx.x == 0) (void)xb_add(&bar[XB_XCNT(b.x)], 1u);
    return b;
}
__device__ __forceinline__ void xcd_barrier_complete(unsigned* bar, unsigned x, unsigned& nloc, unsigned& nx) {
    const unsigned G = gridDim.x * gridDim.y * gridDim.z;
    unsigned sum, cnt, mine, sp = 0u;
    for (;;) {
        sum = 0u; cnt = 0u; mine = 0u;
#pragma unroll
        for (unsigned j = 0; j < 16; ++j) { const unsigned c = xb_ld(&bar[XB_XCNT(j)]); sum += c; cnt += (c > 0u) ? 1u : 0u; mine = (j == x) ? c : mine; }
        if (sum == G) break;
        __builtin_amdgcn_s_sleep(1);
        if ((++sp & 255u) == 0u) { if (xb_ld(&bar[XB_TMO])) break; if (sp > XB_SPIN_CAP) { atomicAdd(&bar[XB_TMO], 1u); break; } }
    }
    nloc = mine > 0u ? mine : 1u; nx = cnt > 0u ? cnt : 1u;
}
__device__ __forceinline__ void xcd_barrier(const XcdBarrier& b, int wave) {
    asm volatile("s_waitcnt vmcnt(0)" ::: "memory");
    __syncthreads();
    if (wave == 0 && __builtin_amdgcn_mbcnt_hi(~0u, __builtin_amdgcn_mbcnt_lo(~0u, 0u)) == 0u) {
        unsigned* bar = b.bar;
        __builtin_amdgcn_s_waitcnt(0);
        unsigned nloc = b.st[0], nx = b.st[1];
        if (nloc == 0u) { xcd_barrier_complete(bar, b.x, nloc, nx); b.st[0] = nloc; b.st[1] = nx; }
        const unsigned old = xb_add(&bar[XB_XSUB(b.x)], 1u);
        const unsigned gen = old / nloc;
        if (old + 1u == (gen + 1u) * nloc) {
            __builtin_amdgcn_fence(__ATOMIC_RELEASE, "agent");
            asm volatile("s_waitcnt vmcnt(0)" ::: "memory");
            const unsigned og = xb_add(&bar[XB_TOP], 1u);
            const unsigned tg = og / nx;
            if (og + 1u == (tg + 1u) * nx) xb_add(&bar[XB_TOPGEN], 1u);
            else XB_SPIN(xb_ld(&bar[XB_TOPGEN]) == tg, bar);
            __builtin_amdgcn_fence(__ATOMIC_ACQUIRE, "agent");
            xb_add(&bar[XB_XGEN(b.x)], 1u);
            asm volatile("s_waitcnt vmcnt(0)" ::: "memory");
        } else {
            XB_SPIN(xb_ld(&bar[XB_XGEN(b.x)]) == gen, bar);
            __builtin_amdgcn_fence(__ATOMIC_ACQUIRE, "agent");
            asm volatile("s_waitcnt vmcnt(0)" ::: "memory");
        }
    }
    __syncthreads();
}

__device__ __forceinline__ int lane_now() { int l = (int)__builtin_amdgcn_mbcnt_hi(~0u, __builtin_amdgcn_mbcnt_lo(~0u, 0u)); asm volatile("" : "+v"(l)); return l; }
#define TIDLANE const int lane = lane_now(); const int tid = F.wave * 64 + lane; (void)tid; (void)lane;

#define dpp_f(oldv, src, ctrl, rmask) __builtin_bit_cast(float, __builtin_amdgcn_update_dpp(__builtin_bit_cast(int, (float)(oldv)), __builtin_bit_cast(int, (float)(src)), ctrl, rmask, 0xf, false))
__device__ __forceinline__ float wave_scan_add(float v) {
    v += dpp_f(0.f, v, 0x111, 0xf); v += dpp_f(0.f, v, 0x112, 0xf); v += dpp_f(0.f, v, 0x114, 0xf); v += dpp_f(0.f, v, 0x118, 0xf);
    v += dpp_f(0.f, v, 0x142, 0xa); v += dpp_f(0.f, v, 0x143, 0xc); return v; }
__device__ __forceinline__ float wave_scan_max(float v) { const float NI = -3.0e38f;
    v = fmaxf(v, dpp_f(NI, v, 0x111, 0xf)); v = fmaxf(v, dpp_f(NI, v, 0x112, 0xf)); v = fmaxf(v, dpp_f(NI, v, 0x114, 0xf)); v = fmaxf(v, dpp_f(NI, v, 0x118, 0xf));
    v = fmaxf(v, dpp_f(NI, v, 0x142, 0xa)); v = fmaxf(v, dpp_f(NI, v, 0x143, 0xc)); return v; }

__device__ __forceinline__ float wave_sum(float v) {
    v = wave_scan_add(v); return __builtin_bit_cast(float, __builtin_amdgcn_readlane(__builtin_bit_cast(int, v), 63)); }
__device__ __forceinline__ float wave_max(float v) {
#pragma unroll
    for (int o = 1; o < 64; o <<= 1) v = fmaxf(v, __shfl_xor(v, o));
    return v;
}
__device__ __forceinline__ unsigned f2bf(float f) { unsigned u = __float_as_uint(f); return (u + 0x7fffu + ((u >> 16) & 1u)) >> 16; }
__device__ __forceinline__ unsigned pk2(float lo, float hi) { return f2bf(lo) | (f2bf(hi) << 16); }
__device__ __forceinline__ float bflo(unsigned w) { return __uint_as_float(w << 16); }
__device__ __forceinline__ float bfhi(unsigned w) { return __uint_as_float(w & 0xffff0000u); }
__device__ __forceinline__ float bf2f(bf16 b) { return __uint_as_float(((unsigned)b) << 16); }
__device__ __forceinline__ unsigned cvt_pk_bf16(float lo, float hi) { unsigned r; asm volatile("v_cvt_pk_bf16_f32 %0, %1, %2" : "=v"(r) : "v"(lo), "v"(hi)); return r; }
__device__ __forceinline__ float sel_mask(float a, float b, unsigned long long m) { float r; asm("v_cndmask_b32 %0, %1, %2, %3" : "=v"(r) : "v"(a), "v"(b), "s"(m)); return r; }
#define UPMASK(st) ((st) == 32 ? 0xFFFFFFFF00000000ull : (st) == 16 ? 0xFFFF0000FFFF0000ull : (st) == 8 ? 0xFF00FF00FF00FF00ull : (st) == 4 ? 0xF0F0F0F0F0F0F0F0ull : (st) == 2 ? 0xCCCCCCCCCCCCCCCCull : 0xAAAAAAAAAAAAAAAAull)
__device__ __forceinline__ float clamp448(float x) { return fminf(fmaxf(x, -448.f), 448.f); }
__device__ __forceinline__ unsigned pack4_fp8(float a, float b, float c, float d) { int r = 0; r = __builtin_amdgcn_cvt_pk_fp8_f32(clamp448(a), clamp448(b), r, false); r = __builtin_amdgcn_cvt_pk_fp8_f32(clamp448(c), clamp448(d), r, true); return (unsigned)r; }
__device__ __forceinline__ unsigned pack4_fp8_nc(float a, float b, float c, float d) { int r = 0; r = __builtin_amdgcn_cvt_pk_fp8_f32(a, b, r, false); r = __builtin_amdgcn_cvt_pk_fp8_f32(c, d, r, true); return (unsigned)r; }
__device__ __forceinline__ float ffma_s(float a, float b, float c) { float r; asm("v_fma_f32 %0, %1, %2, %3" : "=v"(r) : "v"(a), "v"(b), "v"(c)); return r; }
__device__ __forceinline__ float fmul_s(float a, float b) { float r; asm("v_mul_f32_e32 %0, %1, %2" : "=v"(r) : "v"(a), "v"(b)); return r; }
__device__ __forceinline__ float fadd_s(float a, float b) { float r; asm("v_add_f32_e32 %0, %1, %2" : "=v"(r) : "v"(a), "v"(b)); return r; }
__device__ __forceinline__ f32x4 ld4bf(const bf16* p) { const v2u w = *(const v2u*)p; return (f32x4){bflo(w.x), bfhi(w.x), bflo(w.y), bfhi(w.y)}; }
__device__ __forceinline__ void st4bf(bf16* p, f32x4 v) { v2u w; w.x = cvt_pk_bf16(v[0], v[1]); w.y = cvt_pk_bf16(v[2], v[3]); *(v2u*)p = w; }
__device__ __forceinline__ float fmin_s(float a, float b) { float r; asm("v_min_f32_e32 %0, %1, %2" : "=v"(r) : "v"(a), "v"(b)); return r; }
__device__ __forceinline__ float fclamp_s(float x, float lim) { float r; asm("v_med3_f32 %0, %1, -%2, %2" : "=v"(r) : "v"(x), "s"(lim)); return r; }
__device__ __forceinline__ float fmax3_s(float a, float b, float c) { float r; asm("v_max3_f32 %0, %1, %2, %3" : "=v"(r) : "v"(a), "v"(b), "v"(c)); return r; }
__device__ __forceinline__ float fmed3_s(float a, float b, float c) { float r; asm("v_med3_f32 %0, %1, %2, %3" : "=v"(r) : "v"(a), "v"(b), "v"(c)); return r; }
__device__ __forceinline__ float sigmoidf_(float x) { return __builtin_amdgcn_rcpf(1.f + __builtin_amdgcn_exp2f(-1.4426950408889634f * x)); }

namespace pg8 {
constexpr int BM = 256, BK = 64, HALF = 128, HTB = HALF * BK * 2, STAGE_BYTES = 8 * HTB;
__device__ __forceinline__ int lds_byte(int r, int c) { const int st = (r >> 4) * 2 + (c >> 5), rr = r & 15, cc = c & 31, ob = rr * 64 + cc * 2; return st * 1024 + (ob ^ (((ob >> 9) & 1) << 5)); }
__device__ __forceinline__ void stage_rc(int b, int& R, int& C) { const int st = b / 1024, sb = b % 1024, swz = sb ^ (((sb >> 9) & 1) << 5); R = (st >> 1) * 16 + swz / 64; C = (st & 1) * 32 + (swz % 64) / 2; }
__device__ __forceinline__ int perm32(int rho) { const int n = rho >> 4, i = rho & 15; return 8 * (i >> 2) + 4 * n + (i & 3); }

struct Unit { int pm, pn, e, nvalid, rowbase; };

struct DenseOrder {
    static constexpr bool GATHER = false; int nN, nunits, G, c; const char* Bt; size_t tstep;
    __device__ __forceinline__ bool next(int i, Unit& u, int = 0) const { const int L = i * G + c; if (L >= nunits) return false; u.pm = L / nN; u.pn = L - u.pm * nN; u.e = 0; u.nvalid = 256; u.rowbase = u.pm * 256; return true; }
    __device__ __forceinline__ unsigned row_off(const Unit& u, int r, int rb) const { return (unsigned)(u.pm * 256 + r) * (unsigned)rb; }
    __device__ __forceinline__ const char* bptr(const Unit& u) const { return Bt + (size_t)u.pn * tstep; }
};
template <bool GATHER_> struct MoeOrder {
    static constexpr bool GATHER = GATHER_; int nN, G, c; const char* Bt; size_t tstep, estep; const LAS int* tstart; const LAS int* cnt; const int* slot_of;
    __device__ __forceinline__ bool next(int i, Unit& u, int ehint = 0) const {
        const int L = i * G + c; const int rt = L / nN; const int nt = __builtin_amdgcn_readfirstlane(tstart[NEXP]);
        if (rt >= nt) return false;
        int e = ehint; while (__builtin_amdgcn_readfirstlane(tstart[e + 1]) <= rt) ++e;
        const int j = rt - __builtin_amdgcn_readfirstlane(tstart[e]); const int ce = __builtin_amdgcn_readfirstlane(cnt[e]);
        u.pm = rt; u.pn = L - rt * nN; u.e = e; u.nvalid = (ce - j * 256) < 256 ? (ce - j * 256) : 256; u.rowbase = e * T_ALL + j * 256; return true;
    }
    __device__ __forceinline__ unsigned row_off(const Unit& u, int r, int rb) const {
        if (GATHER) { const int v = slot_of[u.rowbase + r]; const int tok = r < u.nvalid ? v >> 2 : 0; return (unsigned)tok * (unsigned)rb; }
        return (unsigned)(u.pm * 256 + r) * (unsigned)rb;
    }
    __device__ __forceinline__ const char* bptr(const Unit& u) const { return Bt + (size_t)u.e * estep + (size_t)u.pn * tstep; }
};

typedef const f32x4 (&AccRef)[2][2][4][2];
typedef f32x4 (&AccMut)[2][2][4][2];
constexpr int TAB_OFF = MISC_OFF + 7168, TAB_BYTES = 3072;
__device__ __forceinline__ void dma16(const char* sbase, unsigned voff, unsigned lds_dst) { unsigned keep;
    asm volatile("s_mov_b32 %0, m0\n\ts_mov_b32 m0, %3\n\ts_nop 0\n\tglobal_load_lds_dwordx4 %2, %1\n\ts_mov_b32 m0, %0" : "=&s"(keep) : "s"(sbase), "v"(voff), "s"(lds_dst) : "memory"); }

struct EpiBf16 {
    static constexpr int SW = 0x7a7a7a7a, SA = 0x7a7a7a7a; static constexpr bool PERM = true, HAS_TAB = false; bf16* O; int ldc;
    __device__ __forceinline__ void operator()(AccRef acc, const Unit& u, const LAS unsigned char*, int wr, int wc, int fr, int fq) const {
        const int row0 = u.pm * BM + wr * 64 + fr, col0 = u.pn * BM + wc * 32 + 8 * fq;
#pragma unroll
        for (int ai = 0; ai < 2; ++ai)
#pragma unroll
            for (int m = 0; m < 4; ++m) { bf16* rowp = O + (size_t)(row0 + ai * HALF + m * 16) * ldc + col0;
#pragma unroll
                for (int bj = 0; bj < 2; ++bj) { const f32x4 v0 = acc[ai][bj][m][0], v1 = acc[ai][bj][m][1];
                    v4u w; w.x = cvt_pk_bf16(v0[0], v0[1]); w.y = cvt_pk_bf16(v0[2], v0[3]); w.z = cvt_pk_bf16(v1[0], v1[1]); w.w = cvt_pk_bf16(v1[2], v1[3]);
                    *(v4u*)(rowp + bj * HALF) = w; } }
    }
};
struct EpiQkvA {
    static constexpr int SW = 0x7a7a7a7a, SA = 0x7a7a7a7a; static constexpr bool PERM = false, HAS_TAB = false; bf16* O;
    __device__ __forceinline__ void operator()(AccRef acc, const Unit& u, const LAS unsigned char*, int wr, int wc, int fr, int fq) const {
        const int row0 = u.pm * BM + wr * 64 + fr, col0 = u.pn * BM + wc * 32 + 4 * fq;
        const bool rope = (u.pm < T_LAT / 256) && (u.pn <= 4);
        float fq4[4];
#pragma unroll
        for (int i = 0; i < 4; ++i) fq4[i] = exp2f(-(float)(4 * fq + i) * (13.287712379549449f / 16.f));
        const int odd = fq & 1;
#pragma unroll
        for (int ai = 0; ai < 2; ++ai)
#pragma unroll
            for (int mp = 0; mp < 2; ++mp) { v2u pa[2][2], pb[2][2];
#pragma unroll
                for (int mm = 0; mm < 2; ++mm) { const int m = 2 * mp + mm; const int row = row0 + ai * HALF + m * 16; const int s = row & (SEQ - 1); const float pos = (float)((wc & 1) ? (s & 63) : (s >> 6));
                    float sn[4], cs[4];
#pragma unroll
                    for (int i = 0; i < 4; ++i) { const float rev = __builtin_amdgcn_fractf(pos * fq4[i] * 0.15915494309189535f); sn[i] = rope ? __builtin_amdgcn_sinf(rev) : 0.f; cs[i] = rope ? __builtin_amdgcn_cosf(rev) : 1.f; }
#pragma unroll
                    for (int bj = 0; bj < 2; ++bj) { const f32x4 u1 = acc[ai][bj][m][0], u2 = acc[ai][bj][m][1]; float o1[4], o2[4];
#pragma unroll
                        for (int i = 0; i < 4; ++i) { o1[i] = u1[i] * cs[i] - u2[i] * sn[i]; o2[i] = u1[i] * sn[i] + u2[i] * cs[i]; }
                        pa[mm][bj].x = cvt_pk_bf16(o1[0], o1[1]); pa[mm][bj].y = cvt_pk_bf16(o1[2], o1[3]); pb[mm][bj].x = cvt_pk_bf16(o2[0], o2[1]); pb[mm][bj].y = cvt_pk_bf16(o2[2], o2[3]); } }
                bf16* rowp = O + (size_t)(row0 + ai * HALF + (2 * mp + odd) * 16) * 1536 + col0 - 4 * odd;
#pragma unroll
                for (int bj = 0; bj < 2; ++bj) {
                    const auto a0 = __builtin_amdgcn_permlane16_swap(pa[0][bj].x, pa[1][bj].x, false, false); const auto a1 = __builtin_amdgcn_permlane16_swap(pa[0][bj].y, pa[1][bj].y, false, false);
                    const auto b0 = __builtin_amdgcn_permlane16_swap(pb[0][bj].x, pb[1][bj].x, false, false); const auto b1 = __builtin_amdgcn_permlane16_swap(pb[0][bj].y, pb[1][bj].y, false, false);
                    *(v4u*)(rowp + bj * HALF) = (v4u){(unsigned)a0[0], (unsigned)a1[0], (unsigned)a0[1], (unsigned)a1[1]};
                    *(v4u*)(rowp + bj * HALF + 16) = (v4u){(unsigned)b0[0], (unsigned)b1[0], (unsigned)b0[1], (unsigned)b1[1]}; } }
    }
};
struct EpiRes {
    static constexpr int SW = 0x7a7a7a7a, SA = 0x7a7a7a7a; static constexpr bool PERM = true, HAS_TAB = false; bf16* X; const float* gmod; float rs;
    __device__ __forceinline__ void operator()(AccRef acc, const Unit& u, const LAS unsigned char*, int wr, int wc, int fr, int fq) const {
        const int row0 = u.pm * BM + wr * 64 + fr, col0 = u.pn * BM + wc * 32 + 8 * fq;
        const int bidx = u.pm < T_LAT / 256 ? u.pm / (SEQ / 256) : 4; const float* g = gmod + bidx * 6144;
        f32x4 gv[2][2];
#pragma unroll
        for (int bj = 0; bj < 2; ++bj)
#pragma unroll
            for (int n = 0; n < 2; ++n) gv[bj][n] = *(const f32x4*)(g + col0 + bj * HALF + 4 * n) * rs;
        v4u xin[2][4][2];
#pragma unroll
        for (int ai = 0; ai < 2; ++ai)
#pragma unroll
            for (int m = 0; m < 4; ++m)
#pragma unroll
                for (int bj = 0; bj < 2; ++bj) xin[ai][m][bj] = *(const v4u*)(X + (size_t)(row0 + ai * HALF + m * 16) * D + col0 + bj * HALF);
        __builtin_amdgcn_sched_barrier(0);
#pragma unroll
        for (int ai = 0; ai < 2; ++ai)
#pragma unroll
            for (int m = 0; m < 4; ++m) { bf16* rowp = X + (size_t)(row0 + ai * HALF + m * 16) * D + col0;
#pragma unroll
                for (int bj = 0; bj < 2; ++bj) { const v4u xw = xin[ai][m][bj]; const unsigned xs[4] = {xw.x, xw.y, xw.z, xw.w}; float y[8];
#pragma unroll
                    for (int q = 0; q < 4; ++q) { const int n = q >> 1, j = 2 * (q & 1);
                        y[2 * q] = ffma_s(gv[bj][n][j], acc[ai][bj][m][n][j], bflo(xs[q])); y[2 * q + 1] = ffma_s(gv[bj][n][j + 1], acc[ai][bj][m][n][j + 1], bfhi(xs[q])); }
                    v4u w; w.x = cvt_pk_bf16(y[0], y[1]); w.y = cvt_pk_bf16(y[2], y[3]); w.z = cvt_pk_bf16(y[4], y[5]); w.w = cvt_pk_bf16(y[6], y[7]);
                    *(v4u*)(rowp + bj * HALF) = w; } }
    }
};
struct EpiSwiglu {
    static constexpr bool PERM = true, HAS_TAB = true; static constexpr int SW = F8_S1, SA = F8_S1; unsigned char* ACT; const float* b_in; const int* slot_of;
    __device__ __forceinline__ void stage(const Unit& u, unsigned lds_slot, int wid, int lane) const { if (wid == 0) dma16((const char*)(b_in + (size_t)u.e * 2048 + u.pn * 256), (unsigned)lane * 16u, lds_slot);
        if (wid == 1) dma16((const char*)(slot_of + u.rowbase), (unsigned)lane * 16u, lds_slot + 1024u); }
    __device__ __forceinline__ void init(f32x4 (&ci)[2][2], const LAS unsigned char* tab, int wc, int fq) const {
        const LAS f32x4* bp = (const LAS f32x4*)(tab + (wc * 32 + 8 * fq) * 8); f32x4 bb[4];
#pragma unroll
        for (int i = 0; i < 4; ++i) bb[i] = bp[i];
#pragma unroll
        for (int n = 0; n < 2; ++n) { ci[0][n] = (f32x4){bb[2 * n][0], bb[2 * n][2], bb[2 * n + 1][0], bb[2 * n + 1][2]}; ci[1][n] = (f32x4){bb[2 * n][1], bb[2 * n][3], bb[2 * n + 1][1], bb[2 * n + 1][3]}; }
    }
    __device__ __forceinline__ void operator()(AccRef acc, const Unit& u, const LAS unsigned char*, int wr, int wc, int fr, int fq) const {
        const int row0 = u.pm * BM + wr * 64 + fr, o0 = u.pn * 128 + wc * 32 + 8 * fq;
        const int odd = fq & 1;
#pragma unroll
        for (int ai = 0; ai < 2; ++ai)
#pragma unroll
            for (int mp = 0; mp < 2; ++mp) { v2u w[2];
#pragma unroll
                for (int mm = 0; mm < 2; ++mm) { const int m = 2 * mp + mm; float o[8];
#pragma unroll
                    for (int n = 0; n < 2; ++n)
#pragma unroll
                        for (int i = 0; i < 4; ++i) { const int j = 4 * n + i; float g = acc[ai][0][m][n][i], up = acc[ai][1][m][n][i];
                            g = fmin_s(g, 7.f); up = ffma_s(fmed3_s(up, -7.f, 7.f), F8_AS, F8_AS); o[j] = (g * up) * __builtin_amdgcn_rcpf(1.f + __builtin_amdgcn_exp2f((-1.702f * 1.4426950408889634f) * g)); }
                    w[mm].x = pack4_fp8_nc(o[0], o[1], o[2], o[3]); w[mm].y = pack4_fp8_nc(o[4], o[5], o[6], o[7]); }
                const auto r0 = __builtin_amdgcn_permlane16_swap(w[0].x, w[1].x, false, false); const auto r1 = __builtin_amdgcn_permlane16_swap(w[0].y, w[1].y, false, false);
                const v4u q = {(unsigned)r0[0], (unsigned)r1[0], (unsigned)r0[1], (unsigned)r1[1]};
                *(v4u*)(ACT + (size_t)(row0 + ai * HALF + (2 * mp + odd) * 16) * DFF + o0 - 8 * odd) = q; }
    }
};
struct EpiMoe2 {
    static constexpr bool PERM = true, HAS_TAB = true; static constexpr int SW = F8_S2, SA = F8_S2; bf16* YS; const float* b_out; const int* slot_of; const float* gate_of;
    __device__ __forceinline__ void stage(const Unit& u, unsigned lds_slot, int wid, int lane) const {
        if (wid == 0) dma16((const char*)(b_out + (size_t)u.e * D + u.pn * 256), (unsigned)lane * 16u, lds_slot);
        if (wid == 1) dma16((const char*)(slot_of + u.rowbase), (unsigned)lane * 16u, lds_slot + 1024u);
        if (wid == 2) dma16((const char*)(gate_of + u.rowbase), (unsigned)lane * 16u, lds_slot + 2048u); }
    __device__ __forceinline__ void init(f32x4 (&ci)[2][2], const LAS unsigned char* tab, int wc, int fq) const {
#pragma unroll
        for (int bj = 0; bj < 2; ++bj)
#pragma unroll
            for (int n = 0; n < 2; ++n) ci[bj][n] = *(const LAS f32x4*)(tab + (bj * HALF + wc * 32 + 8 * fq + 4 * n) * 4);
    }
    __device__ __forceinline__ void operator()(AccRef acc, const Unit& u, const LAS unsigned char* tab, int wr, int wc, int fr, int fq) const {
        const int r0 = wr * 64 + fr, col0 = u.pn * BM + wc * 32 + 8 * fq;
        int slot[8]; float gt[8];
#pragma unroll
        for (int i = 0; i < 8; ++i) { const int r = r0 + (i >> 2) * HALF + (i & 3) * 16; const int sl = *(const LAS int*)(tab + 1024 + r * 4); gt[i] = *(const LAS float*)(tab + 2048 + r * 4); slot[i] = r < u.nvalid ? sl : -1; }
#if YS_F8
        {
            const int odd = fq & 1;
#pragma unroll
            for (int ai = 0; ai < 2; ++ai)
#pragma unroll
                for (int mp = 0; mp < 2; ++mp) { const int ra = r0 + ai * HALF + 2 * mp * 16, rt = ra + 16 * odd;
                    const float ga = *(const LAS float*)(tab + 2048 + ra * 4) * F8_YS, gb = *(const LAS float*)(tab + 2048 + (ra + 16) * 4) * F8_YS;
                    const int sl = *(const LAS int*)(tab + 1024 + rt * 4); const int st = rt < u.nvalid ? sl : -1;
                    unsigned char* rowp = (unsigned char*)YS + (size_t)(st >= 0 ? st : 0) * D + col0 - 8 * odd;
#pragma unroll
                    for (int bj = 0; bj < 2; ++bj) { v2u w[2];
#pragma unroll
                        for (int mm = 0; mm < 2; ++mm) { const int m = 2 * mp + mm; const float g = mm ? gb : ga; f32x4 v0, v1;
#pragma unroll
                            for (int j = 0; j < 4; ++j) { v0[j] = fclamp_s(fmul_s(acc[ai][bj][m][0][j], g), 448.f); v1[j] = fclamp_s(fmul_s(acc[ai][bj][m][1][j], g), 448.f); }
                            w[mm].x = pack4_fp8_nc(v0[0], v0[1], v0[2], v0[3]); w[mm].y = pack4_fp8_nc(v1[0], v1[1], v1[2], v1[3]); }
                        const auto r0 = __builtin_amdgcn_permlane16_swap(w[0].x, w[1].x, false, false); const auto r1 = __builtin_amdgcn_permlane16_swap(w[0].y, w[1].y, false, false);
                        if (st >= 0) *(v4u*)(rowp + bj * HALF) = (v4u){(unsigned)r0[0], (unsigned)r1[0], (unsigned)r0[1], (unsigned)r1[1]}; } }
            return;
        }
#endif
#pragma unroll
        for (int ai = 0; ai < 2; ++ai)
#pragma unroll
            for (int m = 0; m < 4; ++m) { const int i = ai * 4 + m;
                if (slot[i] >= 0) {
#if YS_F8
                    const float g = gt[i] * F8_YS; unsigned char* rowp = (unsigned char*)YS + (size_t)slot[i] * D + col0;
#pragma unroll
                    for (int bj = 0; bj < 2; ++bj) { f32x4 v0, v1;
#pragma unroll
                        for (int j = 0; j < 4; ++j) { v0[j] = fclamp_s(fmul_s(acc[ai][bj][m][0][j], g), 448.f); v1[j] = fclamp_s(fmul_s(acc[ai][bj][m][1][j], g), 448.f); }
                        v2u w; w.x = pack4_fp8_nc(v0[0], v0[1], v0[2], v0[3]); w.y = pack4_fp8_nc(v1[0], v1[1], v1[2], v1[3]);
                        *(v2u*)(rowp + bj * HALF) = w; }
#else
                    const float g = gt[i]; bf16* rowp = YS + (size_t)slot[i] * D + col0;
#pragma unroll
                    for (int bj = 0; bj < 2; ++bj) { f32x4 v0, v1;
#pragma unroll
                        for (int j = 0; j < 4; ++j) { v0[j] = fmul_s(acc[ai][bj][m][0][j], g); v1[j] = fmul_s(acc[ai][bj][m][1][j], g); }
                        v4u w; w.x = cvt_pk_bf16(v0[0], v0[1]); w.y = cvt_pk_bf16(v0[2], v0[3]); w.z = cvt_pk_bf16(v1[0], v1[1]); w.w = cvt_pk_bf16(v1[2], v1[3]);
                        *(v4u*)(rowp + bj * HALF) = w; }
#endif
                } }
    }
};

template <class Epi, class Sched, bool F8 = false>
__device__ __forceinline__ void gemm_phase(LAS unsigned char* lds, const char* A, const int K, const Sched& S, const Epi& E, const int wid) {
    const int lane = lane_now(), tid = wid * 64 + lane, wr = wid >> 2, wc = wid & 3;
    constexpr int ES = F8 ? 1 : 2; const int nt = (K * ES) / (BK * 2); const int rowb = K * ES;
    constexpr bool GA = Sched::GATHER;
    int R0, C0; stage_rc(tid * 16, R0, C0);
    const int Rb0 = Epi::PERM ? ((R0 & ~31) + perm32(R0 & 31)) : R0;
    const unsigned voffB0 = (unsigned)(Rb0 * rowb + C0 * 2), voffA0 = (unsigned)(R0 * rowb + C0 * 2);
    const size_t kstep = (size_t)(BK * 2);
    const size_t r64 = (size_t)64 * rowb;
    const unsigned ldsw = (unsigned)wid * 1024u;
    const unsigned ldsbase = (unsigned)(uintptr_t)lds + ldsw;
    const int aoff = lds_byte(wr * 64 + (lane & 15), (lane >> 4) * 8), boff = lds_byte(wc * 32 + (lane & 15), (lane >> 4) * 8);
#define PG8_SA(b, h) (((b) * 2 + (h)) * HTB)
#define PG8_SB(b, h) ((4 + (b) * 2 + (h)) * HTB)
#define PG8_DMA(bufoff, gptr, voff, i) dma16((const char*)(gptr), (voff), ldsbase + (unsigned)((bufoff) + (i) * 8192))
#define PG8_STAGEB(bufoff, gbase, h) do { PG8_DMA(bufoff, (gbase) + (size_t)(h) * 2 * r64, voffB0, 0); PG8_DMA(bufoff, (gbase) + (size_t)(h) * 2 * r64 + r64, voffB0, 1); } while (0)
#define PG8_STAGEA(bufoff, gbase, h, vv) do { if constexpr (GA) { PG8_DMA(bufoff, gbase, vv[h][0], 0); PG8_DMA(bufoff, gbase, vv[h][1], 1); } \
        else { PG8_DMA(bufoff, (gbase) + (size_t)(h) * 2 * r64, voffA0, 0); PG8_DMA(bufoff, (gbase) + (size_t)(h) * 2 * r64 + r64, voffA0, 1); } } while (0)
#define PG8_LDA(dst, b, h) do { _Pragma("unroll") for (int m = 0; m < 4; ++m) _Pragma("unroll") for (int k = 0; k < 2; ++k) dst[m][k] = *(const LAS bf16x8*)(lds + PG8_SA(b, h) + aoff + m * 2048 + k * 1024); } while (0)
#define PG8_LDB(dst, b, h) do { _Pragma("unroll") for (int n = 0; n < 2; ++n) _Pragma("unroll") for (int k = 0; k < 2; ++k) dst[n][k] = *(const LAS bf16x8*)(lds + PG8_SB(b, h) + boff + n * 2048 + k * 1024); } while (0)
#define PG8_MMA(ai, bj, At, Bt, FIRST) do { __builtin_amdgcn_s_setprio(1); \
        if constexpr (F8) { _Pragma("unroll") for (int m = 0; m < 4; ++m) _Pragma("unroll") for (int n = 0; n < 2; ++n) \
            acc[ai][bj][m][n] = __builtin_amdgcn_mfma_scale_f32_16x16x128_f8f6f4(__builtin_shufflevector(__builtin_bit_cast(v4i, Bt[n][0]), __builtin_bit_cast(v4i, Bt[n][1]), 0, 1, 2, 3, 4, 5, 6, 7), \
                __builtin_shufflevector(__builtin_bit_cast(v4i, At[m][0]), __builtin_bit_cast(v4i, At[m][1]), 0, 1, 2, 3, 4, 5, 6, 7), (FIRST) ? ci[bj][n] : acc[ai][bj][m][n], 0, 0, 0, Epi::SW, 0, Epi::SA); } \
        else { _Pragma("unroll") for (int m = 0; m < 4; ++m) _Pragma("unroll") for (int n = 0; n < 2; ++n) _Pragma("unroll") for (int k = 0; k < 2; ++k) \
            acc[ai][bj][m][n] = __builtin_amdgcn_mfma_f32_16x16x32_bf16(Bt[n][k], At[m][k], ((FIRST) && k == 0) ? ci[bj][n] : acc[ai][bj][m][n], 0, 0, 0); } __builtin_amdgcn_s_setprio(0); } while (0)
#define PG8_WAIT_V(n) asm volatile("s_waitcnt vmcnt(" #n ")" ::: "memory")
#define PG8_WAIT_L(n) asm volatile("s_waitcnt lgkmcnt(" #n ")" ::: "memory")
#define PG8_BAR __builtin_amdgcn_s_barrier()
#define PG8_SCHED __builtin_amdgcn_sched_barrier(0)
#define PG8_LOADV(u, v) do { if constexpr (GA) { _Pragma("unroll") for (int _h = 0; _h < 2; ++_h) _Pragma("unroll") for (int _i = 0; _i < 2; ++_i) v[_h][_i] = S.row_off(u, _h * HALF + _i * 64 + R0, rowb) + (unsigned)(C0 * 2); } } while (0)
#define PG8_ABASE(u) (GA ? A : A + (size_t)(u).pm * 4 * r64)
    Unit cur, nxt; int ui = 0;
    if (!S.next(0, cur)) return;
    const LAS unsigned char* tab0 = lds + (TAB_OFF - 0);
    if constexpr (Epi::HAS_TAB) E.stage(cur, (unsigned)(uintptr_t)tab0, wid, lane);
    f32x4 acc[2][2][4][2];
    f32x4 ci[2][2] = {{{0.f, 0.f, 0.f, 0.f}, {0.f, 0.f, 0.f, 0.f}}, {{0.f, 0.f, 0.f, 0.f}, {0.f, 0.f, 0.f, 0.f}}};
#define PG8_FILL() do { _Pragma("unroll") for (int a_ = 0; a_ < 2; ++a_) _Pragma("unroll") for (int b_ = 0; b_ < 2; ++b_) _Pragma("unroll") for (int m_ = 0; m_ < 4; ++m_) _Pragma("unroll") for (int n_ = 0; n_ < 2; ++n_) acc[a_][b_][m_][n_] = ci[b_][n_]; } while (0)
    bf16x8 At[4][2], B0[2][2], B1[2][2];
    unsigned cv[2][2] = {{0u, 0u}, {0u, 0u}};
    PG8_LOADV(cur, cv);
    const char* cA = PG8_ABASE(cur); const char* cB = S.bptr(cur);
    PG8_STAGEB(PG8_SB(0, 0), cB, 0); PG8_STAGEB(PG8_SB(0, 1), cB, 1); PG8_STAGEA(PG8_SA(0, 0), cA, 0, cv); PG8_STAGEA(PG8_SA(0, 1), cA, 1, cv);
    if (wr == 1) PG8_BAR;
    PG8_WAIT_V(2); PG8_BAR;
    PG8_STAGEB(PG8_SB(1, 0), cB + kstep, 0); PG8_STAGEA(PG8_SA(1, 0), cA + kstep, 0, cv); PG8_STAGEB(PG8_SB(1, 1), cB + kstep, 1);
    PG8_WAIT_V(6); PG8_BAR;
    if constexpr (Epi::HAS_TAB) { E.init(ci, tab0, wc, lane >> 4); PG8_FILL(); }
    for (;;) {
        const bool has_next = S.next(ui + 1, nxt, cur.e);
        if constexpr (Epi::HAS_TAB) { if (has_next) E.stage(nxt, (unsigned)(uintptr_t)tab0 + (unsigned)(((ui + 1) % 3) * TAB_BYTES), wid, lane); }
        const char* nA = has_next ? PG8_ABASE(nxt) : cA; const char* nB = has_next ? S.bptr(nxt) : cB;
#define PG8_ITER(FIRST_) do { \
            const bool last = (t == nt - 2); \
            const char* a1 = cA + (size_t)(t + 1) * kstep; \
            const char* a2 = last ? nA : cA + (size_t)(t + 2) * kstep; const char* b2 = last ? nB : cB + (size_t)(t + 2) * kstep; \
            const char* a3 = a2 + kstep; const char* b3 = b2 + kstep; \
              \
            PG8_LDB(B0, 0, 0); PG8_LDB(B1, 0, 1); PG8_SCHED; PG8_LDA(At, 0, 0); PG8_STAGEA(PG8_SA(1, 1), a1, 1, cv); \
            if constexpr (GA) { if (last && has_next) {            \
                const LAS int* st_ = (const LAS int*)(tab0 + ((ui + 1) % 3) * TAB_BYTES + 1024);     \
_Pragma("unroll") \
                for (int h = 0; h < 2; ++h) \
_Pragma("unroll") \
                    for (int i = 0; i < 2; ++i) { const int r_ = h * HALF + i * 64 + R0; const int v_ = st_[r_]; cv[h][i] = (unsigned)(r_ < nxt.nvalid ? v_ >> 2 : 0) * (unsigned)rowb + (unsigned)(C0 * 2); } } } \
            PG8_WAIT_V(8); PG8_WAIT_L(0); PG8_BAR; PG8_MMA(0, 0, At, B0, FIRST_); PG8_MMA(0, 1, At, B1, FIRST_); PG8_BAR; PG8_SCHED; \
              \
            PG8_LDA(At, 0, 1); PG8_STAGEB(PG8_SB(0, 0), b2, 0); PG8_STAGEB(PG8_SB(0, 1), b2, 1); PG8_STAGEA(PG8_SA(0, 0), a2, 0, cv); \
            PG8_WAIT_V(8); PG8_WAIT_L(0); PG8_BAR; PG8_MMA(1, 0, At, B0, FIRST_); PG8_MMA(1, 1, At, B1, FIRST_); PG8_BAR; PG8_SCHED; \
              \
            PG8_LDB(B0, 1, 0); PG8_LDB(B1, 1, 1); PG8_SCHED; PG8_LDA(At, 1, 0); PG8_STAGEA(PG8_SA(0, 1), a2, 1, cv); \
            PG8_WAIT_V(8); PG8_WAIT_L(0); PG8_BAR; PG8_MMA(0, 0, At, B0, false); PG8_MMA(0, 1, At, B1, false); PG8_BAR; PG8_SCHED; \
              \
            PG8_LDA(At, 1, 1); PG8_STAGEB(PG8_SB(1, 0), b3, 0); PG8_STAGEB(PG8_SB(1, 1), b3, 1); PG8_STAGEA(PG8_SA(1, 0), a3, 0, cv); \
            PG8_WAIT_V(8); PG8_WAIT_L(0); PG8_BAR; PG8_MMA(1, 0, At, B0, false); PG8_MMA(1, 1, At, B1, false); PG8_BAR; PG8_SCHED; \
        } while (0)
        if constexpr (!Epi::HAS_TAB) {
            { const int t = 0; PG8_ITER(true); }
#pragma unroll 1
            for (int t = 2; t < nt; t += 2) PG8_ITER(false);
        } else {
#pragma unroll 1
            for (int t = 0; t < nt; t += 2) PG8_ITER(false);
        }
#undef PG8_ITER
        if (wr == 0) PG8_BAR;
        { const int l_ = lane_now(); E(acc, cur, tab0 + (ui % 3) * TAB_BYTES, wr, wc, l_ & 15, l_ >> 4); }
        if (!has_next) break;
        cur = nxt; cA = nA; cB = nB; ++ui;
        if constexpr (Epi::HAS_TAB) { const int l_ = lane_now(); E.init(ci, tab0 + (ui % 3) * TAB_BYTES, wc, l_ >> 4); PG8_FILL(); }
        if (wr == 1) PG8_BAR;
    }
    PG8_WAIT_V(0);
    PG8_BAR;
#undef PG8_SA
#undef PG8_SB
#undef PG8_DMA
#undef PG8_STAGEA
#undef PG8_STAGEB
#undef PG8_LDA
#undef PG8_LDB
#undef PG8_MMA
#undef PG8_WAIT_V
#undef PG8_WAIT_L
#undef PG8_BAR
#undef PG8_SCHED
#undef PG8_LOADV
#undef PG8_ABASE
#undef PG8_FILL
}
}

struct Args { const float* in[25]; float* out; unsigned char* ws; int ph_lo, ph_hi, stop_layers, fin_combine; };

struct Frame {
    LAS unsigned char* lds; volatile LAS unsigned* MISC; unsigned* ctl;
    int wave, G, vcu, gw, NGW;
    const float* in[25]; unsigned char* ws;
    float* mod; bf16* X; bf16* H; bf16* QKV; bf16* O; bf16* ACT; bf16* YS; int* slot_of; float* gate_of; float* GB; bf16* HD;
};

template <int MODE  , bool F8 = false>
__device__ __forceinline__ void transpose_item(const float* W, int K, int N, int col0, int nblk, void* WTv, LAS float* scr, int item, int lane, float F8_WS = 1.f) {
    const int kb = item / nblk, nb = item % nblk, k0 = 64 * kb, n0 = 32 * nb;
#pragma unroll
    for (int i = 0; i < 32; ++i) { const int kk = 2 * i + (lane >> 5); scr[kk * 33 + (lane & 31)] = W[(size_t)(k0 + kk) * N + col0 + n0 + (lane & 31)]; }
    asm volatile("s_waitcnt lgkmcnt(0)" ::: "memory");
    const int c = lane & 7;
#pragma unroll
    for (int j = 0; j < 4; ++j) { const int n = (lane >> 3) + 8 * j; const LAS float* s = scr + (8 * c) * 33 + n;
        const int nn = n0 + n; int row = nn;
        if (MODE == 1) { const int oo = nn >> 1, bj = nn & 1; row = (oo >> 7) * 256 + bj * 128 + (oo & 127); }
        if (F8) { v2u o; o.x = pack4_fp8(s[0 * 33] * F8_WS, s[1 * 33] * F8_WS, s[2 * 33] * F8_WS, s[3 * 33] * F8_WS); o.y = pack4_fp8(s[4 * 33] * F8_WS, s[5 * 33] * F8_WS, s[6 * 33] * F8_WS, s[7 * 33] * F8_WS);
            *(v2u*)((unsigned char*)WTv + (size_t)row * K + k0 + 8 * c) = o; }
        else { v4u o; o.x = pk2(s[0 * 33], s[1 * 33]); o.y = pk2(s[2 * 33], s[3 * 33]); o.z = pk2(s[4 * 33], s[5 * 33]); o.w = pk2(s[6 * 33], s[7 * 33]);
            *(v4u*)((bf16*)WTv + (size_t)row * K + k0 + 8 * c) = o; } }
    asm volatile("s_waitcnt lgkmcnt(0)" ::: "memory");
}

__device__ __forceinline__ void tr8_item(Frame& F, const float* W, int K, int N, unsigned char* WT, int item, int mode, float scale, int tid, int lane) {
    const int nblk = N >> 9, kb = item / nblk, nb = item - kb * nblk, k0 = 64 * kb, n0 = 512 * nb;
    LAS unsigned char* T = F.lds;
    float v[8][8];
#pragma unroll
    for (int r = 0; r < 8; ++r) { const float* src = W + (size_t)(k0 + 8 * F.wave + r) * N + n0 + lane;
#pragma unroll
        for (int i = 0; i < 8; ++i) v[r][i] = src[64 * i]; }
#pragma unroll
    for (int r = 0; r < 8; ++r)
#pragma unroll
        for (int i = 0; i < 8; i += 2) { const int pk = __builtin_amdgcn_cvt_pk_fp8_f32(clamp448(v[r][i] * scale), clamp448(v[r][i + 1] * scale), 0, false);
            T[(lane + 64 * i) * 68 + 8 * F.wave + r] = (unsigned char)(pk & 0xff); T[(lane + 64 * (i + 1)) * 68 + 8 * F.wave + r] = (unsigned char)((pk >> 8) & 0xff); }
    __syncthreads();
    { unsigned wv[16];
#pragma unroll
      for (int q = 0; q < 16; ++q) wv[q] = *(const LAS unsigned*)(T + tid * 68 + 4 * q);
      const int nn = n0 + tid; int row = nn;
      if (mode & 1) { const int oo = nn >> 1, bj = nn & 1; row = (oo >> 7) * 256 + bj * 128 + (oo & 127); }
      v4u* dst = (v4u*)(WT + (size_t)row * K + k0);
#pragma unroll
      for (int q = 0; q < 4; ++q) dst[q] = (v4u){wv[4 * q], wv[4 * q + 1], wv[4 * q + 2], wv[4 * q + 3]}; }
    __syncthreads();
}

__device__ __forceinline__ void phase_setup(Frame& F) {
    TIDLANE
    {
        const float* c = F.in[I_C]; const float* cc = F.in[I_CCTX]; const float* aw = F.in[I_ADAW]; const float* ab = F.in[I_ADAB];
        LAS float* scs = (LAS float*)F.lds;
        LAS float* red = scs + 5 * D;
        for (int i = tid; i < 5 * D; i += NTHREADS) { const int bi = i >> 10, k = i & (D - 1); const float cv = bi < 4 ? c[bi * D + k] : cc[k]; scs[i] = cv / (1.f + __expf(-cv)); }
        __syncthreads();
        for (int t = blockIdx.x; t < 4 * 96; t += F.G) {
            const int l = t / 96, jb = t % 96; float acc[5] = {0.f, 0.f, 0.f, 0.f, 0.f};
            const float* wp = aw + (size_t)l * D * 6144 + jb * 64 + lane; const int k0 = F.wave * 128;
#pragma unroll 1
            for (int kk = 0; kk < 128; kk += 16) { float wv[16];
#pragma unroll
                for (int u = 0; u < 16; ++u) wv[u] = wp[(size_t)(k0 + kk + u) * 6144];
#pragma unroll
                for (int u4 = 0; u4 < 4; ++u4)
#pragma unroll
                    for (int bi = 0; bi < 5; ++bi) { const f32x4 sv = *(const LAS f32x4*)(scs + bi * D + k0 + kk + 4 * u4);
                        acc[bi] += (sv[0] * wv[4 * u4] + sv[1] * wv[4 * u4 + 1]) + (sv[2] * wv[4 * u4 + 2] + sv[3] * wv[4 * u4 + 3]); } }
#pragma unroll
            for (int bi = 0; bi < 5; ++bi) red[(F.wave * 5 + bi) * 64 + lane] = acc[bi];
            __syncthreads();
            if (tid < 320) { const int bi = tid >> 6, j = tid & 63; float s = ab[l * 6144 + jb * 64 + j];
#pragma unroll
                for (int w = 0; w < 8; ++w) s += red[(w * 5 + bi) * 64 + j];
                F.mod[(size_t)(l * 5 + bi) * 6144 + jb * 64 + j] = s; }
            __syncthreads();
        }
    }
    { const float* rw = F.in[I_RW]; float* rwt = (float*)(F.ws + WS_RWT);
      for (int i = blockIdx.x * NTHREADS + tid; i < 4 * NEXP * D; i += F.G * NTHREADS) { const int l = i >> 15, e = (i >> 10) & 31, k = i & 1023; rwt[i] = rw[((size_t)l * D + k) * NEXP + e]; } }
    { const float* mw = F.in[I_MWIN]; float* gwt = (float*)(F.ws + WS_GWT);
      for (int i = blockIdx.x * NTHREADS + tid; i < 16 * D; i += F.G * NTHREADS) { const int g = i >> 10, k = i & 1023; gwt[i] = mw[(size_t)k * 3088 + 3072 + g]; } }
    {
        LAS float* scr = (LAS float*)(F.lds + F.wave * 16384);
        constexpr int I0 = 2 * 16 * 48, I1 = 2 * 16 * 32, I2 = 16 * 96, I3 = 16 * 32, I4 = 16 * 96, I5 = 16 * 32, I6 = 128 * 16 * 64, I7 = 128 * 16 * 32;
        constexpr int NITEMS = I0 + I1 + I2 + I3 + I4 + I5;
        for (int it = F.gw; it < NITEMS; it += F.NGW) {
            int r = it;
            if (r < I0) { const int j = r / (16 * 48); transpose_item<0, QKV_F8_A != 0>(F.in[I_AWQKV] + (size_t)j * D * 1536, D, 1536, 0, 48, F.ws + WS_AWQKV + (size_t)j * 1536 * D * (QKV_F8_A ? 1 : 2), scr, r % (16 * 48), lane, F8_DS); continue; } r -= I0;
            if (r < I1) { const int j = r / (16 * 32); transpose_item<0, WO_F8 != 0>(F.in[I_AWO] + (size_t)j * D * D, D, D, 0, 32, F.ws + WS_AWO + (size_t)j * D * D * (WO_F8 ? 1 : 2), scr, r % (16 * 32), lane, F8_DS); continue; } r -= I1;
            if (r < I2) { transpose_item<0, QKV_F8_M != 0>(F.in[I_MWIN], D, 3088, 0, 96, F.ws + WS_MWIN, scr, r, lane, F8_DS); continue; } r -= I2;
            if (r < I3) { transpose_item<0, WO_F8 != 0>(F.in[I_MWO], D, D, 0, 32, F.ws + WS_MWO, scr, r, lane, F8_DS); continue; } r -= I3;
            if (r < I4) { transpose_item<0, QKV_F8_N != 0>(F.in[I_NWQKV], D, 3072, 0, 96, F.ws + WS_NWQKV, scr, r, lane, F8_DS); continue; } r -= I4;
            if (r < I5) { transpose_item<0, WO_F8 != 0>(F.in[I_NWO], D, D, 0, 32, F.ws + WS_NWO, scr, r, lane, F8_DS); continue; } r -= I5;
            if (r < I6) { const int j = r / (16 * 64); transpose_item<1, true>(F.in[I_EWIN] + (size_t)j * D * 2048, D, 2048, 0, 64, (unsigned char*)(F.ws + WS_EWIN) + (size_t)j * 2048 * D, scr, r % (16 * 64), lane, F8_W1S); continue; } r -= I6;
            { const int j = r / (16 * 32); transpose_item<0, true>(F.in[I_EWOUT] + (size_t)j * DFF * D, DFF, D, 0, 32, (unsigned char*)(F.ws + WS_EWOUT) + (size_t)j * D * DFF, scr, r % (16 * 32), lane, F8_W2S); }
        }
    }
    __syncthreads();
    {
        constexpr int W1 = 128 * 64, W2 = 128 * 32;
        for (int it = blockIdx.x; it < W1 + W2; it += F.G) {
            if (it < W1) { const int j = it >> 6; tr8_item(F, F.in[I_EWIN] + (size_t)j * D * 2048, D, 2048, (unsigned char*)(F.ws + WS_EWIN) + (size_t)j * 2048 * D, it & 63, 1, F8_W1S, tid, lane); }
            else { const int r = it - W1, j = r >> 5; tr8_item(F, F.in[I_EWOUT] + (size_t)j * DFF * D, DFF, D, (unsigned char*)(F.ws + WS_EWOUT) + (size_t)j * D * DFF, r & 31, 0, F8_W2S, tid, lane); }
        }
    }
}

template <bool FIRST, bool GATES>
__device__ __forceinline__ void phase_pre1(Frame& F, int l, float cs) {
    TIDLANE
    const float* n1g = F.in[I_N1G] + l * D;
    if (GATES) { const f32x4* src = (const f32x4*)(F.ws + WS_GWT); f32x4 gw_[8];
#pragma unroll
        for (int i = 0; i < 8; ++i) gw_[i] = src[tid + NTHREADS * i];
#pragma unroll
        for (int i = 0; i < 8; ++i) ((LAS f32x4*)F.lds)[tid + NTHREADS * i] = gw_[i];
        __syncthreads(); }
    const float mbgv = (GATES && lane < 16) ? F.in[I_MBG][lane] : 0.f; (void)mbgv;
    for (int m = F.gw; m < T_ALL; m += F.NGW) {
        const int bidx = m < T_LAT ? m / SEQ : 4;
        const float* sh = F.mod + (size_t)(l * 5 + bidx) * 6144; const float* sc = sh + D;
        f32x4 tg[4], tsc[4], tsh[4];
#pragma unroll
        for (int j = 0; j < 4; ++j) { tg[j] = ((const f32x4*)n1g)[lane + 64 * j]; tsc[j] = ((const f32x4*)sc)[lane + 64 * j]; tsh[j] = ((const f32x4*)sh)[lane + 64 * j]; }
        f32x4 v[4];
        if (FIRST) { const float* src = m < T_LAT ? F.in[I_X] + (size_t)m * D : F.in[I_CTX] + (size_t)(m - T_LAT) * D;
#pragma unroll
            for (int j = 0; j < 4; ++j) v[j] = ((const f32x4*)src)[lane + 64 * j]; }
        else { const float* g5 = F.mod + (size_t)((l - 1) * 5 + bidx) * 6144 + 5 * D;
#pragma unroll
            for (int j = 0; j < 4; ++j) { v[j] = ld4bf(F.X + (size_t)m * D + 4 * (lane + 64 * j)); f32x4 y = {0.f, 0.f, 0.f, 0.f};
#pragma unroll
                for (int k = 0; k < 4; ++k) {
#if YS_F8
                    const int w = ((const int*)((const unsigned char*)F.YS + (size_t)(m * 4 + k) * D))[lane + 64 * j];
                    y[0] += __builtin_amdgcn_cvt_f32_fp8(w, 0) * (1.f / F8_YS); y[1] += __builtin_amdgcn_cvt_f32_fp8(w, 1) * (1.f / F8_YS); y[2] += __builtin_amdgcn_cvt_f32_fp8(w, 2) * (1.f / F8_YS); y[3] += __builtin_amdgcn_cvt_f32_fp8(w, 3) * (1.f / F8_YS);
#else
                    const v2u w = ((const v2u*)(F.YS + (size_t)(m * 4 + k) * D))[lane + 64 * j]; y[0] += bflo(w.x); y[1] += bfhi(w.x); y[2] += bflo(w.y); y[3] += bfhi(w.y);
#endif
                }
                v[j] = v[j] + ((const f32x4*)g5)[lane + 64 * j] * y * cs; } }
#pragma unroll
        for (int j = 0; j < 4; ++j) st4bf(F.X + (size_t)m * D + 4 * (lane + 64 * j), v[j]);
        float ss = 0.f;
#pragma unroll
        for (int j = 0; j < 4; ++j) ss += (v[j][0] * v[j][0] + v[j][1] * v[j][1]) + (v[j][2] * v[j][2] + v[j][3] * v[j][3]);
        const float r = 1.f / sqrtf(wave_sum(ss) * (1.f / D) + EPS);
        f32x4 h[4];
#pragma unroll
        for (int j = 0; j < 4; ++j) { const f32x4 g = tg[j], a = tsc[j], b = tsh[j];
            h[j] = (v[j] * r * g) * (a + 1.f) + b;
            if (l == 1 ? QKV_F8_M != 0 : l == 2 ? QKV_F8_N != 0 : QKV_F8_A != 0) ((unsigned*)(F.ws + WS_H8 + (size_t)m * D))[lane + 64 * j] = pack4_fp8(h[j][0] * F8_DS, h[j][1] * F8_DS, h[j][2] * F8_DS, h[j][3] * F8_DS);
            else { v2u w; w.x = pk2(h[j][0], h[j][1]); w.y = pk2(h[j][2], h[j][3]); ((v2u*)(F.H + (size_t)m * D))[lane + 64 * j] = w; } }
        if (GATES) {
            const LAS float* wg = (const LAS float*)F.lds; float a[16];
#pragma unroll
            for (int g = 0; g < 16; ++g) { float sacc = 0.f;
#pragma unroll
                for (int j = 0; j < 4; ++j) { const f32x4 w = ((const LAS f32x4*)(wg + g * D))[lane + 64 * j]; sacc += (h[j][0] * w[0] + h[j][1] * w[1]) + (h[j][2] * w[2] + h[j][3] * w[3]); }
                a[g] = sacc; if ((g & 3) == 3) asm volatile("" ::: "memory"); }
#pragma unroll
            for (int st = 8; st >= 1; st >>= 1) {
#pragma unroll
                for (int i = 0; i < st; ++i) { const float keep = sel_mask(a[i], a[i + st], UPMASK(st)), give = sel_mask(a[i + st], a[i], UPMASK(st)); a[i] = keep + __shfl_xor(give, st); } }
            float gsum = a[0]; gsum += __shfl_xor(gsum, 16); gsum += __shfl_xor(gsum, 32);
            if (lane < 16) F.GB[(size_t)m * 16 + lane] = gsum + mbgv;
        }
    }
}

__device__ __forceinline__ void phase_pre2_valu(Frame& F, int l, bool commit, const int nrows) {
    TIDLANE
    const float* n2g = F.in[I_N2G] + l * D; const float* rb = F.in[I_RB] + l * NEXP;
    LAS float* wt = (LAS float*)F.lds;
    { const f32x4* src = (const f32x4*)((const float*)(F.ws + WS_RWT) + (size_t)l * NEXP * D);
      for (int i = tid; i < NEXP * D / 4; i += NTHREADS) ((LAS f32x4*)wt)[i] = src[i]; }
    volatile LAS unsigned* lcnt = F.MISC + 128; volatile LAS unsigned* lbase = F.MISC + 160; volatile LAS unsigned* rec = F.MISC + 256;
    const float rbv = rb[lane & 31];
    if (tid < 32) lcnt[tid] = 0u;
    __syncthreads();
    const int rows_per = nrows / 256;
    const int nblk = 256;
    for (int blk = blockIdx.x; blk < nblk; blk += F.G) {
        f32x4 vn[4];
        { const int m0 = blk * rows_per + F.wave;
#pragma unroll
          for (int j = 0; j < 4; ++j) vn[j] = ld4bf(F.X + (size_t)m0 * D + 4 * (lane + 64 * j)); }
        for (int ri = F.wave; ri < rows_per; ri += NWAVES) {
            const int m = blk * rows_per + ri; const int bidx = m < T_LAT ? m / SEQ : 4;
            f32x4 v[4]; float ss = 0.f;
#pragma unroll
            for (int j = 0; j < 4; ++j) { v[j] = vn[j]; ss += (v[j][0] * v[j][0] + v[j][1] * v[j][1]) + (v[j][2] * v[j][2] + v[j][3] * v[j][3]); }
            if (ri + NWAVES < rows_per) {
#pragma unroll
                for (int j = 0; j < 4; ++j) vn[j] = ld4bf(F.X + (size_t)(m + NWAVES) * D + 4 * (lane + 64 * j)); }
            const float r = 1.f / sqrtf(wave_sum(ss) * (1.f / D) + EPS);
            const float* sh = F.mod + (size_t)(l * 5 + bidx) * 6144 + 3 * D; const float* sc = sh + D;
            f32x4 h[4];
#pragma unroll
            for (int j = 0; j < 4; ++j) { const f32x4 g = ((const f32x4*)n2g)[lane + 64 * j], a = ((const f32x4*)sc)[lane + 64 * j], b = ((const f32x4*)sh)[lane + 64 * j];
                h[j] = (v[j] * r * g) * (a + 1.f) + b;
                ((unsigned*)(F.ws + WS_H8 + (size_t)m * D))[lane + 64 * j] = pack4_fp8(h[j][0] * F8_HS, h[j][1] * F8_HS, h[j][2] * F8_HS, h[j][3] * F8_HS); }
            float a[32];
#define P2_RD(dst, e) do { _Pragma("unroll") for (int j_ = 0; j_ < 4; ++j_) dst[j_] = ((const LAS f32x4*)(wt + (e) * D))[lane + 64 * j_]; } while (0)
#define P2_DOT(dst, w) do { float s_ = 0.f; _Pragma("unroll") for (int j_ = 0; j_ < 4; ++j_) { s_ = __builtin_fmaf(h[j_][0], w[j_][0], s_); s_ = __builtin_fmaf(h[j_][1], w[j_][1], s_); s_ = __builtin_fmaf(h[j_][2], w[j_][2], s_); s_ = __builtin_fmaf(h[j_][3], w[j_][3], s_); } dst = s_; } while (0)
            { f32x4 wa0[4], wa1[4], wb0[4], wb1[4];
              P2_RD(wa0, 0); P2_RD(wa1, 1);
#pragma unroll
              for (int e0 = 0; e0 < 32; e0 += 4) {
                  P2_RD(wb0, e0 + 2); P2_RD(wb1, e0 + 3);
                  __builtin_amdgcn_sched_barrier(0);
                  P2_DOT(a[e0], wa0); P2_DOT(a[e0 + 1], wa1);
                  __builtin_amdgcn_sched_barrier(0);
                  if (e0 + 4 < 32) { P2_RD(wa0, e0 + 4); P2_RD(wa1, e0 + 5); }
                  __builtin_amdgcn_sched_barrier(0);
                  P2_DOT(a[e0 + 2], wb0); P2_DOT(a[e0 + 3], wb1);
                  __builtin_amdgcn_sched_barrier(0);
              } }
#undef P2_RD
#undef P2_DOT
#pragma unroll
            for (int st = 16; st >= 1; st >>= 1) {
#pragma unroll
                for (int i = 0; i < st; ++i) { const float keep = sel_mask(a[i], a[i + st], UPMASK(st)), give = sel_mask(a[i + st], a[i], UPMASK(st)); a[i] = keep + __shfl_xor(give, st); } }
            float logit = a[0]; logit += __shfl_xor(logit, 32); logit += rb[lane & 31];
            int rank = 0; const int me = lane & 31;
#pragma unroll
            for (int k = 1; k < 32; ++k) { const int src = (lane & 32) | ((lane + k) & 31); const float ov = __shfl(logit, src); const int oe = (me + k) & 31; rank += (ov > logit || (ov == logit && oe < me)) ? 1 : 0; }
            unsigned long long bm = __ballot(rank < 4 && lane < 32);
            const int e0 = __ffsll((long long)bm) - 1; bm &= bm - 1; const int e1 = __ffsll((long long)bm) - 1; bm &= bm - 1; const int e2 = __ffsll((long long)bm) - 1; bm &= bm - 1; const int e3 = __ffsll((long long)bm) - 1;
            const float t0 = __shfl(logit, e0), t1 = __shfl(logit, e1), t2 = __shfl(logit, e2), t3 = __shfl(logit, e3);
            const float tm = fmaxf(fmaxf(t0, t1), fmaxf(t2, t3));
            const float x0 = __expf(t0 - tm), x1 = __expf(t1 - tm), x2 = __expf(t2 - tm), x3 = __expf(t3 - tm); const float inv = 1.f / ((x0 + x1) + (x2 + x3));
            if (lane < 4) { const int k = lane; const int e = k == 0 ? e0 : k == 1 ? e1 : k == 2 ? e2 : e3; const float g = (k == 0 ? x0 : k == 1 ? x1 : k == 2 ? x2 : x3) * inv;
                const unsigned lp = __hip_atomic_fetch_add((LAS unsigned*)&lcnt[e], 1u, __ATOMIC_RELAXED, __HIP_MEMORY_SCOPE_WORKGROUP);
                const int ridx = (ri * 4 + k) * 3; rec[ridx] = (unsigned)e | (lp << 8); rec[ridx + 1] = (unsigned)(m * 4 + k); rec[ridx + 2] = __float_as_uint(g); }
        }
        __syncthreads();
        if (tid < 32) { const unsigned n = lcnt[tid]; lbase[tid] = (n && commit) ? xb_add(F.ctl + CW_CNT + (l * 32 + tid) * 64, n) : 0u; }
        __syncthreads();
        if (commit) for (int i = tid; i < rows_per * 4; i += NTHREADS) { const unsigned w0 = rec[i * 3]; const int e = w0 & 255; const unsigned pos = lbase[e] + (w0 >> 8);
            F.slot_of[(size_t)e * T_ALL + pos] = (int)rec[i * 3 + 1]; F.gate_of[(size_t)e * T_ALL + pos] = __uint_as_float(rec[i * 3 + 2]); }
        __syncthreads();
        if (tid < 32) lcnt[tid] = 0u;
        __syncthreads();
    }
}

__device__ __forceinline__ void split_pk(float x0, float x1, unsigned& hi, unsigned& lo) { hi = cvt_pk_bf16(x0, x1); lo = cvt_pk_bf16(x0 - bflo(hi), x1 - bfhi(hi)); }
__device__ __forceinline__ void phase_pre2(Frame& F, int l, bool commit, const int nrows) {
    TIDLANE
    const int w = F.wave, fr = lane & 15, kq = lane >> 4;
    const float* n2g = F.in[I_N2G] + l * D; const float* rb = F.in[I_RB] + l * NEXP;
    constexpr int APITCH = 2064;
    LAS unsigned char* AH = F.lds; LAS unsigned char* AL = F.lds + 16 * APITCH; LAS float* RED = (LAS float*)(F.lds + 32 * APITCH);
    volatile LAS unsigned* lcnt = F.MISC + 128; volatile LAS unsigned* lbase = F.MISC + 160; volatile LAS unsigned* rec = F.MISC + 256;
    bf16x8 Bh[4][2], Bl[4][2];
    { const float* rwt = (const float*)(F.ws + WS_RWT) + (size_t)l * NEXP * D; f32x4 rwa[4][2], rwb[4][2];
#pragma unroll
      for (int ks = 0; ks < 4; ++ks)
#pragma unroll
          for (int nb = 0; nb < 2; ++nb) { const f32x4* p = (const f32x4*)(rwt + (size_t)(fr + 16 * nb) * D + 128 * w + 32 * ks + 8 * kq); rwa[ks][nb] = p[0]; rwb[ks][nb] = p[1]; }
      __builtin_amdgcn_sched_barrier(0);
#pragma unroll
      for (int ks = 0; ks < 4; ++ks)
#pragma unroll
          for (int nb = 0; nb < 2; ++nb) { const f32x4 a = rwa[ks][nb], b = rwb[ks][nb];
              unsigned h0, h1, h2, h3, l0, l1, l2, l3; split_pk(a[0], a[1], h0, l0); split_pk(a[2], a[3], h1, l1); split_pk(b[0], b[1], h2, l2); split_pk(b[2], b[3], h3, l3);
              const v4u hi = {h0, h1, h2, h3}, lo = {l0, l1, l2, l3};
              Bh[ks][nb] = __builtin_bit_cast(bf16x8, hi); Bl[ks][nb] = __builtin_bit_cast(bf16x8, lo); } }
    const float rbv = rb[lane & 31];
    if (tid < 32) lcnt[tid] = 0u;
    __syncthreads();
    const int rows_per = nrows / 256;
    const int nb16 = (rows_per + 15) >> 4;
    for (int blk = blockIdx.x; blk < 256; blk += F.G) {
        v2u xn[2][4];
#pragma unroll
        for (int i = 0; i < 2; ++i) { const int rc = (2 * w + i) < rows_per ? (2 * w + i) : rows_per - 1; const bf16* xp = F.X + (size_t)(blk * rows_per + rc) * D;
#pragma unroll
            for (int j = 0; j < 4; ++j) xn[i][j] = *(const v2u*)(xp + 4 * (lane + 64 * j)); }
        for (int b16 = 0; b16 < nb16; ++b16) {
            f32x4 tg[4], tsc2[2][4], tsh2[2][4];
#pragma unroll
            for (int i = 0; i < 2; ++i) { const int ri_ = 16 * b16 + 2 * w + i; const int m_ = blk * rows_per + (ri_ < rows_per ? ri_ : rows_per - 1); const int bi_ = m_ < T_LAT ? m_ / SEQ : 4;
                const float* sh_ = F.mod + (size_t)(l * 5 + bi_) * 6144 + 3 * D;
#pragma unroll
                for (int j = 0; j < 4; ++j) { if (i == 0) tg[j] = ((const f32x4*)n2g)[lane + 64 * j]; tsc2[i][j] = ((const f32x4*)(sh_ + D))[lane + 64 * j]; tsh2[i][j] = ((const f32x4*)sh_)[lane + 64 * j]; } }
            __builtin_amdgcn_sched_barrier(0);
#pragma unroll
            for (int i = 0; i < 2; ++i) {
                const int ri = 16 * b16 + 2 * w + i; const bool valid = ri < rows_per; const int m = blk * rows_per + (valid ? ri : rows_per - 1);
                f32x4 v[4]; float ss = 0.f;
                const f32x4 (&tsc)[4] = tsc2[i]; const f32x4 (&tsh)[4] = tsh2[i];
#pragma unroll
                for (int j = 0; j < 4; ++j) { const v2u xw = xn[i][j]; v[j] = (f32x4){bflo(xw.x), bfhi(xw.x), bflo(xw.y), bfhi(xw.y)}; ss += (v[j][0] * v[j][0] + v[j][1] * v[j][1]) + (v[j][2] * v[j][2] + v[j][3] * v[j][3]); }
                if (b16 + 1 < nb16) { const int r2 = ri + 16; const bf16* xp = F.X + (size_t)(blk * rows_per + (r2 < rows_per ? r2 : rows_per - 1)) * D;
#pragma unroll
                    for (int j = 0; j < 4; ++j) xn[i][j] = *(const v2u*)(xp + 4 * (lane + 64 * j)); }
                const float r = 1.f / sqrtf(wave_sum(ss) * (1.f / D) + EPS);
#pragma unroll
                for (int j = 0; j < 4; ++j) { const f32x4 g = tg[j], a = tsc[j], b = tsh[j];
                    const f32x4 h = (v[j] * r * g) * (a + 1.f) + b;
                    ((unsigned*)(F.ws + WS_H8 + (size_t)m * D))[lane + 64 * j] = pack4_fp8(h[0] * F8_HS, h[1] * F8_HS, h[2] * F8_HS, h[3] * F8_HS);
                    unsigned h0, h1, l0, l1; split_pk(h[0], h[1], h0, l0); split_pk(h[2], h[3], h1, l1); const v2u hi = {h0, h1}, lo = {l0, l1};
                    *(LAS v2u*)(AH + (2 * w + i) * APITCH + (4 * lane + 256 * j) * 2) = hi; *(LAS v2u*)(AL + (2 * w + i) * APITCH + (4 * lane + 256 * j) * 2) = lo; }
            }
            __syncthreads();
            { f32x4 acc[2] = {{0.f, 0.f, 0.f, 0.f}, {0.f, 0.f, 0.f, 0.f}}; bf16x8 ah[4], al[4];
#pragma unroll
              for (int ks = 0; ks < 4; ++ks) { ah[ks] = *(const LAS bf16x8*)(AH + fr * APITCH + (128 * w + 32 * ks + 8 * kq) * 2); al[ks] = *(const LAS bf16x8*)(AL + fr * APITCH + (128 * w + 32 * ks + 8 * kq) * 2); }
#pragma unroll
              for (int ks = 0; ks < 4; ++ks)
#pragma unroll
                  for (int nb = 0; nb < 2; ++nb) { acc[nb] = __builtin_amdgcn_mfma_f32_16x16x32_bf16(ah[ks], Bh[ks][nb], acc[nb], 0, 0, 0);
                      acc[nb] = __builtin_amdgcn_mfma_f32_16x16x32_bf16(ah[ks], Bl[ks][nb], acc[nb], 0, 0, 0); acc[nb] = __builtin_amdgcn_mfma_f32_16x16x32_bf16(al[ks], Bh[ks][nb], acc[nb], 0, 0, 0); }
#pragma unroll
              for (int nb = 0; nb < 2; ++nb)
#pragma unroll
                  for (int i = 0; i < 4; ++i) RED[(w * 16 + kq * 4 + i) * 32 + 16 * nb + fr] = acc[nb][i]; }
            __syncthreads();
            { const int row16 = 2 * w + (lane >> 5), me = lane & 31, ri = 16 * b16 + row16; const bool valid = ri < rows_per; const int m = blk * rows_per + ri;
              float logit = rbv;
#pragma unroll
              for (int ww = 0; ww < 8; ++ww) logit += RED[(ww * 16 + row16) * 32 + me];
              float lg = logit; const bool up = lane >= 32; int e0, e1, e2, e3; float t0, t1, t2, t3;
#define P2_ROUND(EK, TK) do { const float NI_ = -3.0e38f; float s_ = lg; \
                  s_ = fmaxf(s_, dpp_f(NI_, s_, 0x111, 0xf)); s_ = fmaxf(s_, dpp_f(NI_, s_, 0x112, 0xf)); s_ = fmaxf(s_, dpp_f(NI_, s_, 0x114, 0xf)); s_ = fmaxf(s_, dpp_f(NI_, s_, 0x118, 0xf)); \
                  s_ = fmaxf(s_, dpp_f(NI_, s_, 0x142, 0xa)); \
                  const float mA_ = __builtin_bit_cast(float, __builtin_amdgcn_readlane(__builtin_bit_cast(int, s_), 31)), mB_ = __builtin_bit_cast(float, __builtin_amdgcn_readlane(__builtin_bit_cast(int, s_), 63)); \
                  TK = up ? mB_ : mA_; const unsigned long long bal_ = __ballot(lg == TK); \
                  const int ea_ = __ffs((unsigned)bal_) - 1, eb_ = __ffs((unsigned)(bal_ >> 32)) - 1; EK = up ? eb_ : ea_; if (me == EK) lg = NI_; } while (0)
              P2_ROUND(e0, t0); P2_ROUND(e1, t1); P2_ROUND(e2, t2); P2_ROUND(e3, t3);
#undef P2_ROUND
              const float x0 = 1.f, x1 = __expf(t1 - t0), x2 = __expf(t2 - t0), x3 = __expf(t3 - t0); const float inv = 1.f / ((x0 + x1) + (x2 + x3));
              if (me < 4 && valid) { const int k = me; const int e = k == 0 ? e0 : k == 1 ? e1 : k == 2 ? e2 : e3; const float g = (k == 0 ? x0 : k == 1 ? x1 : k == 2 ? x2 : x3) * inv;
                  const unsigned lp = __hip_atomic_fetch_add((LAS unsigned*)&lcnt[e], 1u, __ATOMIC_RELAXED, __HIP_MEMORY_SCOPE_WORKGROUP);
                  const int ridx = (ri * 4 + k) * 3; rec[ridx] = (unsigned)e | (lp << 8); rec[ridx + 1] = (unsigned)(m * 4 + k); rec[ridx + 2] = __float_as_uint(g); } }
        }
        __syncthreads();
        if (tid < 32) { const unsigned n = lcnt[tid]; lbase[tid] = (n && commit) ? xb_add(F.ctl + CW_CNT + (l * 32 + tid) * 64, n) : 0u; }
        __syncthreads();
        if (commit) for (int i = tid; i < rows_per * 4; i += NTHREADS) { const unsigned w0 = rec[i * 3]; const int e = w0 & 255; const unsigned pos = lbase[e] + (w0 >> 8);
            F.slot_of[(size_t)e * T_ALL + pos] = (int)rec[i * 3 + 1]; F.gate_of[(size_t)e * T_ALL + pos] = __uint_as_float(rec[i * 3 + 2]); }
        __syncthreads();
        if (tid < 32) lcnt[tid] = 0u;
        __syncthreads();
    }
}

__device__ __forceinline__ void moe_tables(Frame& F, int l) {
    TIDLANE
    __syncthreads();
    if (F.wave == 0) {
        const int c = lane < NEXP ? (int)xb_ld(F.ctl + CW_CNT + (l * 32 + lane) * 64) : 0; const int t = (c + 255) >> 8;
        int incl = t;
#pragma unroll
        for (int o = 1; o < 32; o <<= 1) { const int v = __shfl_up(incl, o); if (lane >= o) incl += v; }
        if (lane < NEXP) { F.MISC[64 + lane] = (unsigned)c; F.MISC[16 + lane] = (unsigned)(incl - t); }
        if (lane == NEXP - 1) F.MISC[16 + NEXP] = (unsigned)incl;
    }
    __syncthreads();
}

template <int MODE>
__device__ __forceinline__ void phase_attn_naive(Frame& F, const float* sink, const float* rpb) {
    TIDLANE
    constexpr int LD = MODE == 0 ? 1536 : 3072;
    for (int task = F.gw; task < T_ALL * 16; task += F.NGW) {
        const int m = task >> 4, h = task & 15; const bool isctx = m >= T_LAT;
        const int b = isctx ? (m - T_LAT) / LC : m / SEQ, s = m & (SEQ - 1);
        const int kcol = MODE == 0 ? 1024 + (h >> 2) * 64 : 1024 + h * 64, vcol = MODE == 0 ? 1280 + (h >> 2) * 64 : 2048 + h * 64;
        float q[64];
        { const v4u* qp = (const v4u*)(F.QKV + (size_t)m * LD + h * 64);
#pragma unroll
          for (int i = 0; i < 8; ++i) { const v4u w = qp[i]; q[8 * i] = bflo(w.x) * 0.125f; q[8 * i + 1] = bfhi(w.x) * 0.125f; q[8 * i + 2] = bflo(w.y) * 0.125f; q[8 * i + 3] = bfhi(w.y) * 0.125f;
              q[8 * i + 4] = bflo(w.z) * 0.125f; q[8 * i + 5] = bfhi(w.z) * 0.125f; q[8 * i + 6] = bflo(w.w) * 0.125f; q[8 * i + 7] = bfhi(w.w) * 0.125f; } }
        constexpr int NP = MODE == 0 ? 9 : 6;
        float sc[NP]; int krow[NP];
        const int r = s >> 6, qc = s & 63; int rs = r - 4; rs = rs < 0 ? 0 : (rs > 120 ? 120 : rs); int cst = qc - 8; cst = cst < 0 ? 0 : (cst > 48 ? 48 : cst);
#pragma unroll
        for (int p = 0; p < NP; ++p) {
            bool valid = true; int kr; float bias = 0.f;
            if (p < 4) kr = T_LAT + b * LC + 64 * p + lane;
            else if (MODE == 0) { const int kp = s - 128 + 64 * (p - 4) + lane; valid = !isctx && kp >= 0 && kp < SEQ && kp <= s + 128; kr = b * SEQ + (valid ? kp : 0); }
            else { const int j = 64 * (p - 4) + lane; const int kro = j >> 4, kc = cst + (j & 15); valid = !isctx; kr = b * SEQ + (rs + kro) * 64 + kc;
                   bias = rpb[h * 465 + (rs + kro - r + 7) * 31 + (kc - qc + 15)]; }
            krow[p] = kr; float d = 0.f;
            if (valid) { const v4u* kp_ = (const v4u*)(F.QKV + (size_t)kr * LD + kcol);
#pragma unroll
                for (int i = 0; i < 8; ++i) { const v4u w = kp_[i]; d += q[8 * i] * bflo(w.x) + q[8 * i + 1] * bfhi(w.x) + q[8 * i + 2] * bflo(w.y) + q[8 * i + 3] * bfhi(w.y)
                    + q[8 * i + 4] * bflo(w.z) + q[8 * i + 5] * bfhi(w.z) + q[8 * i + 6] * bflo(w.w) + q[8 * i + 7] * bfhi(w.w); } }
            sc[p] = valid ? d + bias : -INFINITY;
        }
        float mx = MODE == 0 ? sink[h] : -INFINITY;
#pragma unroll
        for (int p = 0; p < NP; ++p) mx = fmaxf(mx, sc[p]);
        mx = wave_max(mx);
        float den = 0.f;
#pragma unroll
        for (int p = 0; p < NP; ++p) { sc[p] = __expf(sc[p] - mx); den += sc[p]; }
        den = wave_sum(den); if (MODE == 0) den += __expf(sink[h] - mx);
        float o = 0.f;
#pragma unroll
        for (int p = 0; p < NP; ++p) { if (p >= 4 && isctx) continue;
            for (int j = 0; j < 64; ++j) { const float pj = __shfl(sc[p], j); const int kr = __shfl(krow[p], j);
                if (pj != 0.f) o += pj * bf2f(F.QKV[(size_t)kr * LD + vcol + lane]); } }
        F.O[(size_t)m * D + h * 64 + lane] = (bf16)f2bf(o / den);
    }
}


typedef float f32x16 __attribute__((ext_vector_type(16)));
typedef short s16x4 __attribute__((ext_vector_type(4)));
typedef short v4i16_t __attribute__((ext_vector_type(4)));
__device__ __forceinline__ s16x4 ds_tr(const LAS unsigned char* p) { return __builtin_bit_cast(s16x4, __builtin_amdgcn_ds_read_tr16_b64_v4i16((LAS v4i16_t*)p)); }
__device__ __forceinline__ int crow(int r, int hi) { return (r & 3) + 8 * (r >> 2) + 4 * hi; }
constexpr int AT_KB = 9216, AT_VB = 8320, AT_VD = 4160;
constexpr float LOG2E = 1.4426950408889634f;

template <int MODE>
__device__ __forceinline__ void phase_attn(Frame& F, const float* sink, const float* rpb, const bool with_ctx) {
    TIDLANE
    constexpr int LD = MODE == 0 ? 1536 : 3072;
    constexpr float NEG = -1e30f;
    const int w = F.wave, r32 = lane & 31, hi = lane >> 5, g16 = lane >> 4, i16 = lane & 15;
    LAS unsigned char* KL = F.lds; LAS unsigned char* VL = F.lds + 2 * AT_KB; LAS float* RPB = (LAS float*)(F.lds + 2 * AT_KB + 2 * AT_VB);
    const int skey = tid >> 3, sch = tid & 7;
    const unsigned kw_off = skey * 144 + sch * 16, vw_off = (sch >> 2) * AT_VD + skey * 64 + (sch & 3) * 16;
    const unsigned vr_off = (4 * (g16 >> 1) + (i16 >> 2)) * 64 + (16 * (g16 & 1) + 4 * (i16 & 3)) * 2;
    const unsigned kr_off = r32 * 144 + hi * 16;
    constexpr int NLAT = 2048; const int NUNITS = with_ctx ? NLAT + 64 : NLAT;
    for (int it = 0;; ++it) {
        const int L = it * F.G + F.vcu; if (L >= NUNITS) break;
        const bool isctx = L >= NLAT;
        int b, head, qrow, kcol, vcol, ntiles, q0 = 0, ltmin = 0, rs_lo = 0, rw = 0, rsw = 0;
        if (MODE == 0) {
            int kvh, qb;
            if (!isctx) { b = L >> 9; kvh = (L >> 7) & 3; qb = L & 127; q0 = qb * 64; qrow = b * SEQ + q0 + 32 * (w & 1) + r32;
                ltmin = qb < 2 ? -qb : -2; const int ltmax = (127 - qb) < 2 ? (127 - qb) : 2; ntiles = 4 + (ltmax - ltmin + 1); }
            else { const int L2 = L - NLAT; b = L2 >> 4; kvh = (L2 >> 2) & 3; qb = L2 & 3; qrow = T_LAT + b * LC + qb * 64 + 32 * (w & 1) + r32; ntiles = 4; }
            head = kvh * 4 + (w >> 1); kcol = 1024 + kvh * 64; vcol = 1280 + kvh * 64;
        } else {
            if (!isctx) { b = L >> 9; head = (L >> 5) & 15; const int rg = L & 31; const int r0 = rg * 4; qrow = b * SEQ + r0 * 64 + 32 * w + r32;
                rs_lo = r0 - 4; rs_lo = rs_lo < 0 ? 0 : (rs_lo > 120 ? 120 : rs_lo); int rs_hi = r0 - 1; rs_hi = rs_hi < 0 ? 0 : (rs_hi > 120 ? 120 : rs_hi);
                ntiles = 4 + (rs_hi + 8 - rs_lo); rw = r0 + (w >> 1); rsw = rw - 4; rsw = rsw < 0 ? 0 : (rsw > 120 ? 120 : rsw); }
            else { const int L2 = L - NLAT; b = L2 >> 4; head = L2 & 15; qrow = T_LAT + b * LC + 32 * w + r32; ntiles = 4; }
            kcol = 1024 + head * 64; vcol = 2048 + head * 64;
        }
        bf16x8 qf[4];
#pragma unroll
        for (int ks = 0; ks < 4; ++ks) qf[ks] = *(const bf16x8*)(F.QKV + (size_t)qrow * LD + head * 64 + 16 * ks + 8 * hi);
        float mrun = MODE == 0 ? sink[head] * 8.f : NEG, lrun = MODE == 0 ? 1.f : 0.f;
        f32x16 o0, o1, o2;
#pragma unroll
        for (int r = 0; r < 16; ++r) { o0[r] = 0.f; o1[r] = 0.f; o2[r] = 0.f; }
        const int qc = (MODE == 0 ? 32 * (w & 1) : 32 * (w & 1)) + r32;
        int cst = qc - 8; cst = cst < 0 ? 0 : (cst > 48 ? 48 : cst);
#define AT_ROWBASE(t) ((t) < 4 ? T_LAT + b * LC + 64 * (t) : (MODE == 0 ? b * SEQ + q0 + 64 * (ltmin + (t) - 4) : b * SEQ + (rs_lo + (t) - 4) * 64))
        v4u kr0, vr0, kr1 = {0u, 0u, 0u, 0u}, vr1 = {0u, 0u, 0u, 0u};
        { const bf16* rp = F.QKV + (size_t)(AT_ROWBASE(0) + skey) * LD + sch * 8; kr0 = *(const v4u*)(rp + kcol); vr0 = *(const v4u*)(rp + vcol); }
        float rpbv = 0.f; if (MODE == 1 && tid < 465) rpbv = rpb[head * 465 + tid] * 8.f;
        __syncthreads();
        if (MODE == 1 && tid < 465) RPB[tid] = rpbv;
        *(LAS v4u*)(KL + kw_off) = kr0; *(LAS v4u*)(VL + vw_off) = vr0;
        { const bf16* rp = F.QKV + (size_t)(AT_ROWBASE(1) + skey) * LD + sch * 8; kr0 = *(const v4u*)(rp + kcol); vr0 = *(const v4u*)(rp + vcol); }
        __syncthreads();
#define AT_BIAS(SV, R0_, R1_, KOFF) do { float bb_[16]; \
            _Pragma("unroll") \
                for (int r = (R0_); r < (R1_); ++r) { int d_ = crow(r, hi) + (KOFF) - qc + 15; d_ = d_ < 0 ? 0 : (d_ > 30 ? 30 : d_); bb_[r] = bp[d_]; } \
                __builtin_amdgcn_sched_barrier(0); \
            _Pragma("unroll") \
                for (int r = (R0_); r < (R1_); ++r) SV[r] = ((unsigned)(crow(r, hi) + (KOFF) - cst) < 16u) ? SV[r] + bb_[r] : NEG; } while (0)
#define AT_ITER(T_, LK, LV, WK_, WV_) do { const int t = (T_); const int buf = t & 1; \
            if (t + 2 < ntiles) { const bf16* rp = F.QKV + (size_t)(AT_ROWBASE(t + 2) + skey) * LD + sch * 8; LK = *(const v4u*)(rp + kcol); LV = *(const v4u*)(rp + vcol); } \
            bool active = true; int kr = 0; \
            if (MODE == 1 && t >= 4) { kr = rs_lo + t - 4; active = (kr >= rsw) && (kr < rsw + 8); } \
            if (active) { \
                const LAS unsigned char* Kb = KL + buf * AT_KB + kr_off; const LAS unsigned char* Vb = VL + buf * AT_VB + vr_off; \
                f32x16 s0, s1; \
            _Pragma("unroll") \
                for (int r = 0; r < 16; ++r) { s0[r] = 0.f; s1[r] = 0.f; } \
                bf16x8 kf0[4], kf1[4]; \
            _Pragma("unroll") \
                for (int ks = 0; ks < 4; ++ks) { kf0[ks] = *(const LAS bf16x8*)(Kb + ks * 32); kf1[ks] = *(const LAS bf16x8*)(Kb + 32 * 144 + ks * 32); } \
                __builtin_amdgcn_sched_barrier(0); \
            _Pragma("unroll") \
                for (int ks = 0; ks < 4; ++ks) { s0 = __builtin_amdgcn_mfma_f32_32x32x16_bf16(kf0[ks], qf[ks], s0, 0, 0, 0); s1 = __builtin_amdgcn_mfma_f32_32x32x16_bf16(kf1[ks], qf[ks], s1, 0, 0, 0); } \
                __builtin_amdgcn_sched_barrier(0); \
                constexpr float C2 = 0.125f * LOG2E; \
                if (MODE == 0 && t >= 4) { const int lt = ltmin + t - 4; \
                    if (lt == -2 || lt == 2) { const int d0 = 64 * lt - qc; \
            _Pragma("unroll") \
                        for (int r = 0; r < 16; ++r) { const int dd0 = d0 + crow(r, hi), dd1 = dd0 + 32; if (dd0 > 128 || dd0 < -128) s0[r] = NEG; if (dd1 > 128 || dd1 < -128) s1[r] = NEG; } } } \
                  \
                  \
                const bool nwin = (MODE == 1) && t >= 4; const bool lowc = (w & 1) == 0; \
                if (nwin) { const LAS float* bp = RPB + (kr - rw + 7) * 31; \
                    if (lowc) { AT_BIAS(s0, 0, 16, 0); AT_BIAS(s1, 0, 4, 32); } else { AT_BIAS(s0, 12, 16, 0); AT_BIAS(s1, 0, 16, 32); } } \
                float mt, mt2; \
                if (nwin && lowc) { mt = fmax3_s(s0[0], s1[0], s0[2]); mt2 = fmax3_s(s0[1], s1[1], s0[3]); mt = fmax3_s(mt, s1[2], s0[4]); mt2 = fmax3_s(mt2, s1[3], s0[5]); \
            _Pragma("unroll") \
                    for (int r = 6; r < 16; r += 2) { mt = fmaxf(mt, s0[r]); mt2 = fmaxf(mt2, s0[r + 1]); } } \
                else if (nwin) { mt = fmax3_s(s1[0], s0[12], s0[14]); mt2 = fmax3_s(s1[1], s0[13], s0[15]); \
            _Pragma("unroll") \
                    for (int r = 2; r < 16; r += 2) { mt = fmaxf(mt, s1[r]); mt2 = fmaxf(mt2, s1[r + 1]); } } \
                else { mt = fmaxf(s0[0], s1[0]); mt2 = fmaxf(s0[1], s1[1]); \
            _Pragma("unroll") \
                    for (int r = 2; r < 16; r += 2) { mt = fmax3_s(mt, s0[r], s1[r]); mt2 = fmax3_s(mt2, s0[r + 1], s1[r + 1]); } } \
                mt = fmaxf(mt, mt2); \
                mt = fmaxf(mt, __shfl_xor(mt, 32)); \
                if (__any(mt > mrun + (8.f / C2))) {        \
                    const float mn = fmaxf(mrun, mt), alpha = __builtin_amdgcn_exp2f((mrun - mn) * C2); mrun = mn; lrun *= alpha; \
            _Pragma("unroll") \
                    for (int r = 0; r < 16; ++r) { o0[r] *= alpha; o1[r] *= alpha; o2[r] *= alpha; } } \
                const float negm = -mrun * C2; \
                if (nwin && lowc) { \
            _Pragma("unroll") \
                    for (int r = 0; r < 16; ++r) { s0[r] = __builtin_amdgcn_exp2f(__builtin_fmaf(s0[r], C2, negm)); s1[r] = r < 4 ? __builtin_amdgcn_exp2f(__builtin_fmaf(s1[r], C2, negm)) : 0.f; } } \
                else if (nwin) { \
            _Pragma("unroll") \
                    for (int r = 0; r < 16; ++r) { s1[r] = __builtin_amdgcn_exp2f(__builtin_fmaf(s1[r], C2, negm)); s0[r] = r >= 12 ? __builtin_amdgcn_exp2f(__builtin_fmaf(s0[r], C2, negm)) : 0.f; } } \
                else { \
            _Pragma("unroll") \
                    for (int r = 0; r < 16; ++r) { s0[r] = __builtin_amdgcn_exp2f(__builtin_fmaf(s0[r], C2, negm)); s1[r] = __builtin_amdgcn_exp2f(__builtin_fmaf(s1[r], C2, negm)); } } \
                const int sskip = nwin ? (lowc ? 3 : 0) : -1; \
                bf16x8 pf[4]; \
            _Pragma("unroll") \
                for (int s = 0; s < 4; ++s) { const f32x16& sv = (s < 2) ? s0 : s1; const int rb = 8 * (s & 1); \
                    v4u pk; pk.x = cvt_pk_bf16(sv[rb], sv[rb + 1]); pk.y = cvt_pk_bf16(sv[rb + 2], sv[rb + 3]); pk.z = cvt_pk_bf16(sv[rb + 4], sv[rb + 5]); pk.w = cvt_pk_bf16(sv[rb + 6], sv[rb + 7]); \
                    pf[s] = __builtin_bit_cast(bf16x8, pk); } \
            _Pragma("unroll") \
                for (int s = 0; s < 4; ++s) if (s != sskip) { \
                    const s16x4 a0 = ds_tr(Vb + s * 1024), a1 = ds_tr(Vb + s * 1024 + 512), c0 = ds_tr(Vb + AT_VD + s * 1024), c1 = ds_tr(Vb + AT_VD + s * 1024 + 512); \
                    const bf16x8 v0 = (bf16x8){a0[0], a0[1], a0[2], a0[3], a1[0], a1[1], a1[2], a1[3]}, v1 = (bf16x8){c0[0], c0[1], c0[2], c0[3], c1[0], c1[1], c1[2], c1[3]}; \
                    o0 = __builtin_amdgcn_mfma_f32_32x32x16_bf16(v0, pf[s], o0, 0, 0, 0); o1 = __builtin_amdgcn_mfma_f32_32x32x16_bf16(v1, pf[s], o1, 0, 0, 0); \
                    o2 = __builtin_amdgcn_mfma_f32_32x32x16_bf16((bf16x8){0x3F80, 0x3F80, 0x3F80, 0x3F80, 0x3F80, 0x3F80, 0x3F80, 0x3F80}, pf[s], o2, 0, 0, 0); } \
            } \
            if (t + 1 < ntiles) { *(LAS v4u*)(KL + (buf ^ 1) * AT_KB + kw_off) = WK_; *(LAS v4u*)(VL + (buf ^ 1) * AT_VB + vw_off) = WV_; } \
            __syncthreads(); } while (0)
        for (int tt = 0; tt < ntiles; tt += 2) { AT_ITER(tt, kr1, vr1, kr0, vr0); if (tt + 1 < ntiles) AT_ITER(tt + 1, kr0, vr0, kr1, vr1); }
#undef AT_ITER
#undef AT_BIAS
#undef AT_ROWBASE
        const float inv = 1.f / (lrun + o2[0]);
        if (WO_F8) { unsigned char* op8 = (unsigned char*)F.O + (size_t)qrow * D + head * 64 + 16 * hi; const float sc8 = inv * F8_DS;
            unsigned da[4], db[4];
#pragma unroll
            for (int rr = 0; rr < 4; ++rr) { da[rr] = pack4_fp8(o0[4 * rr] * sc8, o0[4 * rr + 1] * sc8, o0[4 * rr + 2] * sc8, o0[4 * rr + 3] * sc8);
                db[rr] = pack4_fp8(o1[4 * rr] * sc8, o1[4 * rr + 1] * sc8, o1[4 * rr + 2] * sc8, o1[4 * rr + 3] * sc8); }
#define AT_SW(A_, B_) do { const auto r_ = __builtin_amdgcn_permlane32_swap(A_, B_, false, false); A_ = r_[0]; B_ = r_[1]; } while (0)
            AT_SW(da[0], da[1]); AT_SW(da[2], da[3]); AT_SW(da[0], da[2]); AT_SW(da[1], da[3]);
            AT_SW(db[0], db[1]); AT_SW(db[2], db[3]); AT_SW(db[0], db[2]); AT_SW(db[1], db[3]);
#undef AT_SW
            *(v4u*)op8 = (v4u){da[0], da[1], da[2], da[3]}; *(v4u*)(op8 + 32) = (v4u){db[0], db[1], db[2], db[3]}; }
        else {
        bf16* op = F.O + (size_t)qrow * D + head * 64 + 4 * hi;
#pragma unroll
        for (int rr = 0; rr < 4; ++rr) { v2u a, c; a.x = cvt_pk_bf16(o0[4 * rr] * inv, o0[4 * rr + 1] * inv); a.y = cvt_pk_bf16(o0[4 * rr + 2] * inv, o0[4 * rr + 3] * inv);
            c.x = cvt_pk_bf16(o1[4 * rr] * inv, o1[4 * rr + 1] * inv); c.y = cvt_pk_bf16(o1[4 * rr + 2] * inv, o1[4 * rr + 3] * inv);
            *(v2u*)(op + 8 * rr) = a; *(v2u*)(op + 32 + 8 * rr) = c; } }

    }
}

__device__ __forceinline__ int chain_tok(int dir, int b, int p) { return dir == 0 ? (p < LC ? T_LAT + b * LC + p : b * SEQ + (p - LC)) : (p < LC ? T_LAT + b * LC + (LC - 1 - p) : b * SEQ + (SEQ - 1 - (p - LC))); }
__device__ __forceinline__ void phase_mlstm_naive(Frame& F) {
    TIDLANE
    for (int task = blockIdx.x; task < 64; task += F.G) {
        const int cidx = task >> 1, dvh = task & 1, b = cidx >> 3, hh = (cidx >> 1) & 3, dir = cidx & 1;
        const int dv = dvh * 128 + (tid >> 2), qt = tid & 3;
        float C[32], n[32];
#pragma unroll
        for (int j = 0; j < 32; ++j) { C[j] = 0.f; n[j] = 0.f; }
        float mst = -1e30f;
#define tok(p) chain_tok(dir, b, (p))
        v4u kk[4], qq[4]; float vv, ig, fg;
        { const int m = tok(0); const bf16* row = F.QKV + (size_t)m * 3072;
#pragma unroll
          for (int i = 0; i < 4; ++i) { kk[i] = ((const v4u*)(row + 512 + hh * 128 + qt * 32))[i]; qq[i] = ((const v4u*)(row + hh * 128 + qt * 32))[i]; }
          vv = bf2f(row[1024 + hh * 256 + dv]); ig = F.GB[(size_t)m * 16 + dir * 8 + hh]; fg = F.GB[(size_t)m * 16 + dir * 8 + 4 + hh]; }
        for (int p = 0; p < LC + SEQ; ++p) {
            const int m = tok(p);
            v4u kn[4], qn[4]; float vn = 0.f, in_ = 0.f, fn = 0.f;
            if (p + 1 < LC + SEQ) { const int m2 = tok(p + 1); const bf16* row = F.QKV + (size_t)m2 * 3072;
#pragma unroll
                for (int i = 0; i < 4; ++i) { kn[i] = ((const v4u*)(row + 512 + hh * 128 + qt * 32))[i]; qn[i] = ((const v4u*)(row + hh * 128 + qt * 32))[i]; }
                vn = bf2f(row[1024 + hh * 256 + dv]); in_ = F.GB[(size_t)m2 * 16 + dir * 8 + hh]; fn = F.GB[(size_t)m2 * 16 + dir * 8 + 4 + hh]; }
            else {
#pragma unroll
                for (int i = 0; i < 4; ++i) { kn[i] = kk[i]; qn[i] = qq[i]; } }
            const float lf = fminf(fg, 0.f) - log1pf(__expf(-fabsf(fg)));
            const float mn = fmaxf(lf + mst, ig); const float fd = __expf(lf + mst - mn), iw = __expf(ig - mn); mst = mn;
            const float ivk = iw * vv * 0.08838834764831845f, iwk = iw * 0.08838834764831845f;
            float num = 0.f, den = 0.f;
#pragma unroll
            for (int i = 0; i < 4; ++i) { const unsigned kw[4] = {kk[i].x, kk[i].y, kk[i].z, kk[i].w}, qw[4] = {qq[i].x, qq[i].y, qq[i].z, qq[i].w};
#pragma unroll
                for (int j = 0; j < 4; ++j) { const int e0 = 8 * i + 2 * j; const float k0 = bflo(kw[j]), k1 = bfhi(kw[j]), q0 = bflo(qw[j]), q1 = bfhi(qw[j]);
                    C[e0] = fd * C[e0] + ivk * k0; C[e0 + 1] = fd * C[e0 + 1] + ivk * k1; n[e0] = fd * n[e0] + iwk * k0; n[e0 + 1] = fd * n[e0 + 1] + iwk * k1;
                    num += C[e0] * q0 + C[e0 + 1] * q1; den += n[e0] * q0 + n[e0 + 1] * q1; } }
            num += __shfl_xor(num, 1); num += __shfl_xor(num, 2); den += __shfl_xor(den, 1); den += __shfl_xor(den, 2);
            if (qt == 0) F.HD[((size_t)dir * T_ALL + m) * D + hh * 256 + dv] = (bf16)f2bf(num / fmaxf(fabsf(den), __expf(-mn)));
#pragma unroll
            for (int i = 0; i < 4; ++i) { kk[i] = kn[i]; qq[i] = qn[i]; }
            vv = vn; ig = in_; fg = fn;
        }
    }
#undef tok
}


constexpr int ML_QT = 0, ML_KT = 17408, ML_WK = 34816, ML_VT = 51456, ML_CI = 55616, ML_NT = 64320, ML_TA = 64832, ML_RED = 65536, ML_REDD = 98304;
constexpr float KSC = 0.08838834764831845f;

__device__ __forceinline__ v4u scale_bf16x8(v4u x, float s) {
    v4u o; o.x = cvt_pk_bf16(bflo(x.x) * s, bfhi(x.x) * s); o.y = cvt_pk_bf16(bflo(x.y) * s, bfhi(x.y) * s); o.z = cvt_pk_bf16(bflo(x.z) * s, bfhi(x.z) * s); o.w = cvt_pk_bf16(bflo(x.w) * s, bfhi(x.w) * s); return o;
}

__device__ __forceinline__ void phase_mlstm(Frame& F) {
    TIDLANE
    const int w = F.wave, r32 = lane & 31, hi = lane >> 5, g16 = lane >> 4, i16 = lane & 15;
    const int tb = w >> 2, kh = w & 1, sb = tb == 0 ? (w < 2 ? 1 : 0) : (w >= 6 ? 1 : 0), q4 = 2 * kh + sb;
    const bool st = (w & 2) == 0; const int sw = (w & 1) + 2 * (w >> 2);
    LAS unsigned char* QT = F.lds + ML_QT; LAS unsigned char* KT = F.lds + ML_KT; LAS unsigned char* WK = F.lds + ML_WK; LAS unsigned char* VT = F.lds + ML_VT; LAS unsigned char* CI = F.lds + ML_CI;
    LAS float* NT = (LAS float*)(F.lds + ML_NT); LAS float* TA = (LAS float*)(F.lds + ML_TA); LAS float* RED = (LAS float*)(F.lds + ML_RED); LAS float* REDD = (LAS float*)(F.lds + ML_REDD);
    const unsigned vr_off = (4 * (g16 >> 1) + (i16 >> 2)) * 64 + (16 * (g16 & 1) + 4 * (i16 & 3)) * 2;
    const int stok = tid >> 3, sdk = 8 * (tid & 7);
    const int vtok = tid >> 2, vpc = tid & 3;
    constexpr int NCH = (LC + SEQ) / 64;
    for (int task = F.vcu; task < 256; task += F.G) {
        const int cidx = task >> 3, ds = task & 7, b = cidx >> 3, hh = (cidx >> 1) & 3, dir = cidx & 1;
        f32x16 accC;
#pragma unroll
        for (int r = 0; r < 16; ++r) accC[r] = 0.f;
        float m_c = -1e30f; f32x16 nacc;
#pragma unroll
        for (int r = 0; r < 16; ++r) nacc[r] = 0.f;
        __syncthreads();
        for (int i = tid; i < (8704 + 512) / 4; i += NTHREADS) ((LAS unsigned*)CI)[i] = 0u;
        v4u qreg[2], kreg[2], vreg = {0u, 0u, 0u, 0u}; float gi, gf;
#define CH_BASE(c) __builtin_amdgcn_readfirstlane(dir == 0 ? ((c) < 4 ? T_LAT + b * LC + 64 * (c) : b * SEQ + 64 * ((c) - 4)) : ((c) < 4 ? T_LAT + b * LC + (LC - 1) - 64 * (c) : b * SEQ + (SEQ - 1) - 64 * ((c) - 4)))
#define CH_TOK(cb, pos) (dir == 0 ? (cb) + (pos) : (cb) - (pos))
#define ML_LOAD(c) do { const int cb_ = CH_BASE(c); const int m_ = CH_TOK(cb_, stok); const bf16* row_ = F.QKV + (size_t)m_ * 3072; \
            qreg[0] = *(const v4u*)(row_ + hh * 128 + sdk); qreg[1] = *(const v4u*)(row_ + hh * 128 + 64 + sdk); kreg[0] = *(const v4u*)(row_ + 512 + hh * 128 + sdk); kreg[1] = *(const v4u*)(row_ + 512 + hh * 128 + 64 + sdk); \
            if (tid < 256) { const int mv_ = CH_TOK(cb_, vtok); vreg = *(const v4u*)(F.QKV + (size_t)mv_ * 3072 + 1024 + hh * 256 + ds * 32 + 8 * vpc); } \
            const int mg_ = CH_TOK(cb_, lane); gi = F.GB[(size_t)mg_ * 16 + dir * 8 + hh]; gf = F.GB[(size_t)mg_ * 16 + dir * 8 + 4 + hh]; } while (0)
        ML_LOAD(0);
        for (int c = 0; c < NCH; ++c) {
            const float lf = fminf(gf, 0.f) - __logf(1.f + __expf(-fabsf(gf)));
            const float bc = wave_scan_add(lf);
            const float av = gi - bc; const float pm = wave_scan_max(av);
            const float Bc = __builtin_bit_cast(float, __builtin_amdgcn_readlane(__builtin_bit_cast(int, bc), 63)), amax = __builtin_bit_cast(float, __builtin_amdgcn_readlane(__builtin_bit_cast(int, pm), 63));
            const float mnext = Bc + fmaxf(m_c, amax), gg = fmaxf(pm, m_c);
            const float wgt = __expf(av + Bc - mnext) * KSC, nmv = -(bc + gg), inter = __expf(m_c - gg), decay = __expf(Bc + m_c - mnext);
            { const float wst = __shfl(wgt, 8 * w + (lane >> 3));
              *(LAS v4u*)(QT + stok * 272 + sdk * 2) = qreg[0]; *(LAS v4u*)(QT + stok * 272 + 128 + sdk * 2) = qreg[1];
              *(LAS v4u*)(KT + stok * 272 + sdk * 2) = kreg[0]; *(LAS v4u*)(KT + stok * 272 + 128 + sdk * 2) = kreg[1];
              *(LAS v4u*)(WK + (sdk >> 5) * AT_VD + stok * 64 + (sdk & 31) * 2) = scale_bf16x8(kreg[0], wst);
              *(LAS v4u*)(WK + (2 + (sdk >> 5)) * AT_VD + stok * 64 + (sdk & 31) * 2) = scale_bf16x8(kreg[1], wst);
              if (tid < 256) *(LAS v4u*)(VT + vtok * 64 + vpc * 16) = vreg;
              if (w == 0) TA[lane] = av * LOG2E; }
            const float nm_out = __shfl(nmv, 8 * w + (lane >> 3));
            __syncthreads();
            const float gTl = __shfl(gg, 32 * tb + r32) * LOG2E + 3.5f, interT = __shfl(inter, 32 * tb + r32);
            bf16x8 qf[4], kfr[4], qa[2], cfr[2]; f32x4 nt0[2], nt1[2]; s16x4 pv0[2], pv1[2];
#pragma unroll
            for (int k = 0; k < 4; ++k) { qf[k] = *(const LAS bf16x8*)(QT + (32 * tb + r32) * 272 + (64 * kh + 16 * k + 8 * hi) * 2); kfr[k] = *(const LAS bf16x8*)(KT + (32 * sb + r32) * 272 + (64 * kh + 16 * k + 8 * hi) * 2); }
#pragma unroll
            for (int k = 0; k < 2; ++k) { qa[k] = *(const LAS bf16x8*)(QT + (32 * tb + r32) * 272 + (32 * q4 + 16 * k + 8 * hi) * 2); cfr[k] = *(const LAS bf16x8*)(CI + r32 * 272 + (32 * q4 + 16 * k + 8 * hi) * 2); }
#pragma unroll
            for (int s = 0; s < 2; ++s) { pv0[s] = ds_tr(VT + vr_off + (2 * sb + s) * 1024); pv1[s] = ds_tr(VT + vr_off + (2 * sb + s) * 1024 + 512); }
            __builtin_amdgcn_sched_barrier(0);
            f32x16 sacc, apv, ain;
#pragma unroll
            for (int r = 0; r < 16; ++r) { sacc[r] = 0.f; apv[r] = 0.f; ain[r] = 0.f; }
            f32x16 Ua, Un;
#pragma unroll
            for (int r = 0; r < 16; ++r) { Ua[r] = 0.f; Un[r] = 0.f; }
            if (st) { const bf16x8 ones = (bf16x8){0x3F80, 0x3F80, 0x3F80, 0x3F80, 0x3F80, 0x3F80, 0x3F80, 0x3F80}; s16x4 wk0[4], wk1[4], vt0[4], vt1[4];
#pragma unroll
                for (int s = 0; s < 4; ++s) { wk0[s] = ds_tr(WK + sw * AT_VD + vr_off + s * 1024); wk1[s] = ds_tr(WK + sw * AT_VD + vr_off + s * 1024 + 512); vt0[s] = ds_tr(VT + vr_off + s * 1024); vt1[s] = ds_tr(VT + vr_off + s * 1024 + 512); }
#pragma unroll
                for (int s = 0; s < 4; ++s) { const s16x4 a0 = wk0[s], a1 = wk1[s], b0 = vt0[s], b1 = vt1[s];
                    const bf16x8 af = (bf16x8){a0[0], a0[1], a0[2], a0[3], a1[0], a1[1], a1[2], a1[3]}, bfr = (bf16x8){b0[0], b0[1], b0[2], b0[3], b1[0], b1[1], b1[2], b1[3]};
                    Ua = __builtin_amdgcn_mfma_f32_32x32x16_bf16(af, bfr, Ua, 0, 0, 0);
                    Un = __builtin_amdgcn_mfma_f32_32x32x16_bf16(af, ones, Un, 0, 0, 0); } }
#pragma unroll
            for (int k = 0; k < 2; ++k) ain = __builtin_amdgcn_mfma_f32_32x32x16_bf16(cfr[k], qa[k], ain, 0, 0, 0);
#pragma unroll
            for (int k = 0; k < 2; ++k) { nt0[k] = *(const LAS f32x4*)(NT + 32 * q4 + 16 * k + 8 * hi); nt1[k] = *(const LAS f32x4*)(NT + 32 * q4 + 16 * k + 8 * hi + 4); }
            float den_in = 0.f;
#pragma unroll
            for (int k = 0; k < 2; ++k) { const v4u qw = __builtin_bit_cast(v4u, qa[k]); const f32x4 n0 = nt0[k], n1 = nt1[k];
                den_in += n0[0] * bflo(qw.x) + n0[1] * bfhi(qw.x) + n0[2] * bflo(qw.y) + n0[3] * bfhi(qw.y) + n1[0] * bflo(qw.z) + n1[1] * bfhi(qw.z) + n1[2] * bflo(qw.w) + n1[3] * bfhi(qw.w); }
            den_in += __shfl_xor(den_in, 32);
            float den_s = 0.f;
            if (sb <= tb) {
#pragma unroll
                for (int k = 0; k < 4; ++k) sacc = __builtin_amdgcn_mfma_f32_32x32x16_bf16(kfr[k], qf[k], sacc, 0, 0, 0);
                f32x4 ta4[4];
#pragma unroll
                for (int rr = 0; rr < 4; ++rr) ta4[rr] = *(const LAS f32x4*)(TA + 32 * sb + 8 * rr + 4 * hi);
                if (sb == tb) {
#pragma unroll
                    for (int rr = 0; rr < 4; ++rr) { const f32x4 a4 = ta4[rr];
#pragma unroll
                        for (int j = 0; j < 4; ++j) { const int sp = 8 * rr + 4 * hi + j; const float dm = __builtin_amdgcn_exp2f(a4[j] - gTl);
                            const float p = (sp <= r32) ? sacc[4 * rr + j] * dm : 0.f; sacc[4 * rr + j] = p; den_s += p; } }
                } else {
#pragma unroll
                    for (int rr = 0; rr < 4; ++rr) { const f32x4 a4 = ta4[rr];
#pragma unroll
                        for (int j = 0; j < 4; ++j) { const float p = sacc[4 * rr + j] * __builtin_amdgcn_exp2f(a4[j] - gTl); sacc[4 * rr + j] = p; den_s += p; } }
                }
                den_s += __shfl_xor(den_s, 32);
                bf16x8 pf[2];
#pragma unroll
                for (int s = 0; s < 2; ++s) { const int rb = 8 * s;
                    v4u pk; pk.x = cvt_pk_bf16(sacc[rb], sacc[rb + 1]); pk.y = cvt_pk_bf16(sacc[rb + 2], sacc[rb + 3]); pk.z = cvt_pk_bf16(sacc[rb + 4], sacc[rb + 5]); pk.w = cvt_pk_bf16(sacc[rb + 6], sacc[rb + 7]);
                    pf[s] = __builtin_bit_cast(bf16x8, pk); }
#pragma unroll
                for (int s = 0; s < 2; ++s) { const s16x4 a0 = pv0[s], a1 = pv1[s];
                    const bf16x8 vf = (bf16x8){a0[0], a0[1], a0[2], a0[3], a1[0], a1[1], a1[2], a1[3]};
                    apv = __builtin_amdgcn_mfma_f32_32x32x16_bf16(vf, pf[s], apv, 0, 0, 0); }
            }
            if (c + 1 < NCH) ML_LOAD(c + 1);
            { LAS f32x4* rp = (LAS f32x4*)(RED + (w * 64 + lane) * 16);
#pragma unroll
              for (int rr = 0; rr < 4; ++rr) { f32x4 v; v[0] = apv[4 * rr] + interT * ain[4 * rr]; v[1] = apv[4 * rr + 1] + interT * ain[4 * rr + 1]; v[2] = apv[4 * rr + 2] + interT * ain[4 * rr + 2]; v[3] = apv[4 * rr + 3] + interT * ain[4 * rr + 3]; rp[rr] = v; }
              if (hi == 0) REDD[w * 32 + r32] = den_s + interT * den_in; }
            if (st) {
#pragma unroll
                for (int r = 0; r < 16; ++r) { accC[r] = __builtin_fmaf(decay, accC[r], Ua[r]); nacc[r] = __builtin_fmaf(decay, nacc[r], Un[r]); } }
            __syncthreads();
            if (st) {
#pragma unroll
                for (int rr = 0; rr < 4; ++rr) { v2u o; o.x = cvt_pk_bf16(accC[4 * rr], accC[4 * rr + 1]); o.y = cvt_pk_bf16(accC[4 * rr + 2], accC[4 * rr + 3]); *(LAS v2u*)(CI + r32 * 272 + (32 * sw + 8 * rr + 4 * hi) * 2) = o; } }
            if (st && r32 == 0) {
#pragma unroll
                for (int rr = 0; rr < 4; ++rr) *(LAS f32x4*)(NT + 32 * sw + 8 * rr + 4 * hi) = (f32x4){nacc[4 * rr], nacc[4 * rr + 1], nacc[4 * rr + 2], nacc[4 * rr + 3]}; }
            { const int t = tid >> 3, q = tid & 7, tbo = t >> 5, lo = (t & 31) + 32 * (q & 1);
              f32x4 num = {0.f, 0.f, 0.f, 0.f}; float den = 0.f;
#pragma unroll
              for (int k4 = 0; k4 < 4; ++k4) { const int wv = 4 * tbo + k4; num = num + *(const LAS f32x4*)(RED + (wv * 64 + lo) * 16 + 4 * (q >> 1)); den += REDD[wv * 32 + (t & 31)]; }
              const float dd = 1.f / fmaxf(fabsf(den), __expf(nm_out));
              const int mo = CH_TOK(CH_BASE(c), t);
              const f32x4 hv = num * dd; v2u hw; hw.x = cvt_pk_bf16(hv[0], hv[1]); hw.y = cvt_pk_bf16(hv[2], hv[3]);
              *(v2u*)(F.HD + ((size_t)dir * T_ALL + mo) * D + hh * 256 + ds * 32 + 4 * q) = hw; }
            m_c = mnext;
        }
#undef ML_LOAD
#undef CH_TOK
#undef CH_BASE
    }
}

__device__ __forceinline__ void phase_mlstm_readout(Frame& F) {
    TIDLANE
    const float* hn = F.in[I_MHN];
    f32x4 g[4];
#pragma unroll
    for (int j = 0; j < 4; ++j) g[j] = ((const f32x4*)hn)[lane + 64 * j];
    for (int m = F.gw; m < T_ALL; m += F.NGW) {
        v2u a[4], b2[4], ow[4];
#pragma unroll
        for (int j = 0; j < 4; ++j) { a[j] = ((const v2u*)(F.HD + (size_t)m * D))[lane + 64 * j]; b2[j] = ((const v2u*)(F.HD + ((size_t)T_ALL + m) * D))[lane + 64 * j]; ow[j] = ((const v2u*)(F.QKV + (size_t)m * 3072 + 2048))[lane + 64 * j]; }
        __builtin_amdgcn_sched_barrier(0);
#pragma unroll
        for (int j = 0; j < 4; ++j) {
            const f32x4 v = {bflo(a[j].x) + bflo(b2[j].x), bfhi(a[j].x) + bfhi(b2[j].x), bflo(a[j].y) + bflo(b2[j].y), bfhi(a[j].y) + bfhi(b2[j].y)}; const float ss = wave_sum((v[0] * v[0] + v[1] * v[1]) + (v[2] * v[2] + v[3] * v[3]));
            const float r = 1.f / sqrtf(ss * (1.f / 256.f) + EPS);
            const float o0 = v[0] * r * g[j][0] * sigmoidf_(bflo(ow[j].x)), o1 = v[1] * r * g[j][1] * sigmoidf_(bfhi(ow[j].x)), o2 = v[2] * r * g[j][2] * sigmoidf_(bflo(ow[j].y)), o3 = v[3] * r * g[j][3] * sigmoidf_(bfhi(ow[j].y));
            if (WO_F8) ((unsigned*)((unsigned char*)F.O + (size_t)m * D))[lane + 64 * j] = pack4_fp8(o0 * F8_DS, o1 * F8_DS, o2 * F8_DS, o3 * F8_DS);
            else { v2u w; w.x = pk2(o0, o1); w.y = pk2(o2, o3); ((v2u*)(F.O + (size_t)m * D))[lane + 64 * j] = w; }
        }
    }
}

__device__ __forceinline__ void phase_final(Frame& F, float* out, int combine_layer) {
    TIDLANE
    const float* fg = F.in[I_FG]; f32x4 fgv[4];
#pragma unroll
    for (int j = 0; j < 4; ++j) fgv[j] = ((const f32x4*)fg)[lane + 64 * j];
    for (int m = F.gw; m < T_LAT; m += F.NGW) {
        f32x4 v[4]; float ss = 0.f;
#if YS_F8
        v2u xr[4]; int yr[4][4]; f32x4 g5r[4];
        { const float* g5 = F.mod + (size_t)((combine_layer >= 0 ? combine_layer : 0) * 5 + m / SEQ) * 6144 + 5 * D;
#pragma unroll
          for (int j = 0; j < 4; ++j) { xr[j] = *(const v2u*)(F.X + (size_t)m * D + 4 * (lane + 64 * j)); g5r[j] = ((const f32x4*)g5)[lane + 64 * j];
#pragma unroll
              for (int k = 0; k < 4; ++k) yr[j][k] = combine_layer >= 0 ? ((const int*)((const unsigned char*)F.YS + (size_t)(m * 4 + k) * D))[lane + 64 * j] : 0; } }
        __builtin_amdgcn_sched_barrier(0);
#endif
#pragma unroll
        for (int j = 0; j < 4; ++j) {
#if YS_F8
            v[j] = (f32x4){bflo(xr[j].x), bfhi(xr[j].x), bflo(xr[j].y), bfhi(xr[j].y)};
#else
            v[j] = ld4bf(F.X + (size_t)m * D + 4 * (lane + 64 * j));
#endif
            if (combine_layer >= 0) { const float* g5 = F.mod + (size_t)(combine_layer * 5 + m / SEQ) * 6144 + 5 * D; f32x4 y = {0.f, 0.f, 0.f, 0.f};
#pragma unroll
                for (int k = 0; k < 4; ++k) {
#if YS_F8
                    const int w = yr[j][k];
                    y[0] += __builtin_amdgcn_cvt_f32_fp8(w, 0) * (1.f / F8_YS); y[1] += __builtin_amdgcn_cvt_f32_fp8(w, 1) * (1.f / F8_YS); y[2] += __builtin_amdgcn_cvt_f32_fp8(w, 2) * (1.f / F8_YS); y[3] += __builtin_amdgcn_cvt_f32_fp8(w, 3) * (1.f / F8_YS);
#else
                    const v2u w = ((const v2u*)(F.YS + (size_t)(m * 4 + k) * D))[lane + 64 * j]; y[0] += bflo(w.x); y[1] += bfhi(w.x); y[2] += bflo(w.y); y[3] += bfhi(w.y);
#endif
                }
#if YS_F8
                (void)g5; v[j] = v[j] + g5r[j] * y; }
#else
                v[j] = v[j] + ((const f32x4*)g5)[lane + 64 * j] * y; }
#endif
            ss += (v[j][0] * v[j][0] + v[j][1] * v[j][1]) + (v[j][2] * v[j][2] + v[j][3] * v[j][3]); }
        const float r = 1.f / sqrtf(wave_sum(ss) * (1.f / D) + EPS);
#pragma unroll
        for (int j = 0; j < 4; ++j) ((f32x4*)(out + (size_t)m * D))[lane + 64 * j] = v[j] * r * fgv[j];
    }
}

constexpr int NPH = 31;
#ifndef PROBE_MASK
#define PROBE_MASK 0ull
#endif
#ifndef PROBE_N
#define PROBE_N 3
#endif
#ifndef MLSTM_MFMA
#define MLSTM_MFMA 1
#endif
#if MLSTM_MFMA
#define MLSTM_CALL() phase_mlstm(F)
#else
#define MLSTM_CALL() phase_mlstm_naive(F)
#endif
#ifndef ATTN_MFMA
#define ATTN_MFMA 1
#endif
#if ATTN_MFMA
#define ATTN_CALL(M, a, b, wc) phase_attn<M>(F, a, b, wc)
#else
#define ATTN_CALL(M, a, b, wc) phase_attn_naive<M>(F, a, b)
#endif

__global__ void __launch_bounds__(NTHREADS, 2) fwd(Args args) {
    extern __shared__ __attribute__((aligned(16))) unsigned char lds_raw[];
    Frame F;
    F.lds = (LAS unsigned char*)lds_raw;
    F.MISC = (volatile LAS unsigned*)(F.lds + MISC_OFF);
    F.wave = __builtin_amdgcn_readfirstlane(threadIdx.x >> 6);
    F.G = gridDim.x; { const int bx = blockIdx.x; F.vcu = (F.G % 8 == 0) ? (bx % 8) * (F.G / 8) + bx / 8 : bx; }
    F.gw = blockIdx.x * NWAVES + F.wave; F.NGW = F.G * NWAVES;
#pragma unroll
    for (int i = 0; i < 25; ++i) F.in[i] = args.in[i];
    F.ws = args.ws; unsigned char* ws = args.ws;
    F.ctl = (unsigned*)(ws + WS_CTL);
    F.mod = (float*)(ws + WS_MOD); F.X = (bf16*)(ws + WS_X); F.H = (bf16*)(ws + WS_H); F.QKV = (bf16*)(ws + WS_QKV); F.O = (bf16*)(ws + WS_O);
    F.ACT = (bf16*)(ws + WS_ACT); F.YS = (bf16*)(ws + WS_YS); F.slot_of = (int*)(ws + WS_SLOT); F.gate_of = (float*)(ws + WS_GATE); F.GB = (float*)(ws + WS_GB); F.HD = (bf16*)(ws + WS_HD);
    for (int u = threadIdx.x; u < (LDS_BYTES - MISC_OFF) / 4; u += NTHREADS) ((LAS unsigned*)(F.lds + MISC_OFF))[u] = 0u;
    __syncthreads();
    XcdBarrier bar = xcd_barrier_post(F.ctl + CW_BAR, F.MISC + 8);
    const int lo = args.ph_lo, hi = args.ph_hi;
#define IN(k) (lo <= (k) && (k) < hi)
#define SEAM(k) do { if (IN(k) && IN((k) + 1)) xcd_barrier(bar, F.wave); } while (0)
#define NREP(k) ((((unsigned long long)(PROBE_MASK) >> (k)) & 1ull) ? (PROBE_N) : 1)
#define PH(k, ...) do { if (IN(k)) { { const int rep_ = 0; (void)rep_; __VA_ARGS__ } if (NREP(k) >= 2) { const int rep_ = 1; (void)rep_; __VA_ARGS__ } if (NREP(k) >= 3) { const int rep_ = 2; (void)rep_; __VA_ARGS__ } } SEAM(k); } while (0)
#define DENSE_A(f8) ((f8) ? (const void*)(ws + WS_H8) : (const void*)F.H)
#define DENSE_GEMM(EPI, EOBJ, f8, Btptr, N_) DENSE_GEMM_M(EPI, EOBJ, DENSE_A(f8), Btptr, N_, T_ALL / 256, f8)
#define DENSE_GEMM_M(EPI, EOBJ, Aptr, Btptr, N_, NM_, F8_) do { pg8::DenseOrder S_; S_.nN = (N_) / 256; S_.nunits = (NM_) * S_.nN; S_.G = F.G; S_.c = F.vcu; S_.Bt = (const char*)(Btptr); S_.tstep = (size_t)256 * D * ((F8_) ? 1 : 2); \
        pg8::gemm_phase<EPI, pg8::DenseOrder, (F8_) != 0>(F.lds, (const char*)(Aptr), D, S_, EOBJ, F.wave); } while (0)
#define MOE_PHASES(l, p0) do { \
    PH(p0, phase_pre2(F, l, rep_ == 0, (l) == 3 ? T_LAT : T_ALL);); \
    PH((p0) + 1, moe_tables(F, l); pg8::MoeOrder<true> S_; S_.nN = 8; S_.G = F.G; S_.c = F.vcu; S_.Bt = (const char*)(ws + WS_EWIN) + (size_t)(l) * 32 * 2048 * D; S_.tstep = (size_t)256 * D; S_.estep = (size_t)2048 * D; \
        S_.tstart = (const LAS int*)(F.lds + MISC_OFF + 64); S_.cnt = (const LAS int*)(F.lds + MISC_OFF + 256); S_.slot_of = F.slot_of; \
        pg8::EpiSwiglu E_{(unsigned char*)F.ACT, F.in[I_EBIN] + (size_t)(l) * 32 * 2048, F.slot_of}; pg8::gemm_phase<pg8::EpiSwiglu, pg8::MoeOrder<true>, true>(F.lds, (const char*)(ws + WS_H8), D, S_, E_, F.wave); ); \
    PH((p0) + 2, if (!IN((p0) + 1)) moe_tables(F, l);   pg8::MoeOrder<false> S_; S_.nN = 4; S_.G = F.G; S_.c = F.vcu; S_.Bt = (const char*)(ws + WS_EWOUT) + (size_t)(l) * 32 * D * DFF; S_.tstep = (size_t)256 * DFF; S_.estep = (size_t)D * DFF; \
        S_.tstart = (const LAS int*)(F.lds + MISC_OFF + 64); S_.cnt = (const LAS int*)(F.lds + MISC_OFF + 256); S_.slot_of = F.slot_of; \
        pg8::EpiMoe2 E_{F.YS, F.in[I_EBOUT] + (size_t)(l) * 32 * D, F.slot_of, F.gate_of}; pg8::gemm_phase<pg8::EpiMoe2, pg8::MoeOrder<false>, true>(F.lds, (const char*)F.ACT, DFF, S_, E_, F.wave); ); } while (0)
#define WO_PHASE(l, p, Wt) PH(p, pg8::EpiRes E_{F.X, F.mod + (size_t)((l) * 5) * 6144 + 2 * D, rep_ == 0 ? 1.f : 0.f}; DENSE_GEMM_M(pg8::EpiRes, E_, F.O, Wt, 1024, (l) == 3 ? T_LAT / 256 : T_ALL / 256, WO_F8);)

    PH(0, phase_setup(F););
    PH(1, phase_pre1<true, false>(F, 0, 1.f););
    PH(2, pg8::EpiQkvA E_{F.QKV}; DENSE_GEMM(pg8::EpiQkvA, E_, QKV_F8_A, ws + WS_AWQKV, 1536););
    PH(3, ATTN_CALL(0, F.in[I_ASINK], nullptr, true););
    WO_PHASE(0, 4, ws + WS_AWO);
    MOE_PHASES(0, 5);
    PH(8, phase_pre1<false, true>(F, 1, rep_ == 0 ? 1.f : 0.f););
    PH(9, pg8::EpiBf16 E_{F.QKV, 3072}; DENSE_GEMM(pg8::EpiBf16, E_, QKV_F8_M, ws + WS_MWIN, 3072););
    PH(10, MLSTM_CALL(););
    PH(11, phase_mlstm_readout(F););
    WO_PHASE(1, 12, ws + WS_MWO);
    MOE_PHASES(1, 13);
    PH(16, phase_pre1<false, false>(F, 2, rep_ == 0 ? 1.f : 0.f););
    PH(17, pg8::EpiBf16 E_{F.QKV, 3072}; DENSE_GEMM(pg8::EpiBf16, E_, QKV_F8_N, ws + WS_NWQKV, 3072););
    PH(18, ATTN_CALL(1, nullptr, F.in[I_NRPB], true););
    WO_PHASE(2, 19, ws + WS_NWO);
    MOE_PHASES(2, 20);
    PH(23, phase_pre1<false, false>(F, 3, rep_ == 0 ? 1.f : 0.f););
    PH(24, pg8::EpiQkvA E_{F.QKV}; DENSE_GEMM(pg8::EpiQkvA, E_, QKV_F8_A, ws + WS_AWQKV + (size_t)1536 * D * (QKV_F8_A ? 1 : 2), 1536););
    PH(25, ATTN_CALL(0, F.in[I_ASINK] + 16, nullptr, false););
    WO_PHASE(3, 26, ws + WS_AWO + (size_t)D * D * (WO_F8 ? 1 : 2));
    MOE_PHASES(3, 27);
    PH(30, phase_final(F, args.out, args.fin_combine););
#undef IN
#undef SEAM
}

#ifndef MK_PER_PHASE
#define MK_PER_PHASE 0
#endif
#ifndef MK_STOP
#define MK_STOP 30
#endif

extern "C" void kernel_launch(void* const* d_in, const int* in_sizes, int n_in, void* d_out, int out_size, void* d_ws, size_t ws_size, hipStream_t stream) {
    static int grid = 0;
    if (grid == 0) {
        if (n_in != 25 || out_size != T_LAT * D || ws_size < WS_END) { fprintf(stderr, "kernel_launch: unexpected shapes n_in %d out %d ws %zu (need %zu)\n", n_in, out_size, ws_size, (size_t)WS_END); grid = -1; return; }
        int dev = 0, cus = 0, per_cu = 0;
        (void)hipGetDevice(&dev); (void)hipDeviceGetAttribute(&cus, hipDeviceAttributeMultiprocessorCount, dev);
        (void)hipFuncSetAttribute((const void*)fwd, hipFuncAttributeMaxDynamicSharedMemorySize, LDS_BYTES);
        (void)hipOccupancyMaxActiveBlocksPerMultiprocessor(&per_cu, (const void*)fwd, NTHREADS, LDS_BYTES);
        (void)hipGetLastError();
        grid = cus;
        fprintf(stderr, "kernel_launch: grid %d, occupancy query %d, ws %zu\n", grid, per_cu, ws_size);
    }
    if (grid < 0) return;
    (void)hipMemsetAsync((char*)d_ws + WS_CTL, 0, CTL_BYTES, stream);
    Args a{};
    for (int i = 0; i < 25; ++i) a.in[i] = (const float*)d_in[i];
    a.out = (float*)d_out; a.ws = (unsigned char*)d_ws; a.stop_layers = 0;
    a.fin_combine = MK_STOP >= 30 ? 3 : MK_STOP == 23 ? 2 : MK_STOP == 16 ? 1 : MK_STOP == 8 ? 0 : -1;
#if MK_PER_PHASE
    for (int p = 0; p < NPH; ++p) { if (p >= MK_STOP && p != 30) continue; a.ph_lo = p; a.ph_hi = p + 1; hipLaunchKernelGGL(fwd, dim3(grid), dim3(NTHREADS), LDS_BYTES, stream, a); }
#else
    a.ph_lo = 0; a.ph_hi = NPH; hipLaunchKernelGGL(fwd, dim3(grid), dim3(NTHREADS), LDS_BYTES, stream, a);
#endif
}
```

```cpp
#include <hip/hip_runtime.h>
#include <cstdio>
#include <cstdint>

#define GAS __attribute__((address_space(1)))
#define LAS __attribute__((address_space(3)))
typedef unsigned short bf16;
typedef float f32x4 __attribute__((ext_vector_type(4)));
typedef float f32x2 __attribute__((ext_vector_type(2)));
typedef unsigned v4u __attribute__((ext_vector_type(4)));
typedef unsigned v2u __attribute__((ext_vector_type(2)));
typedef short bf16x8 __attribute__((ext_vector_type(8)));
typedef int v8i __attribute__((ext_vector_type(8)));
typedef int v4i __attribute__((ext_vector_type(4)));

constexpr int D = 1024, NB = 4, SEQ = 8192, LC = 256, NEXP = 32, DFF = 1024;
constexpr int T_LAT = NB * SEQ, T_CTX = NB * LC, T_ALL = T_LAT + T_CTX;
constexpr float EPS = 1e-6f;
constexpr int NTHREADS = 512, NWAVES = 8;
#ifndef QKV_F8_A
#define QKV_F8_A 1
#endif
#ifndef QKV_F8_M
#define QKV_F8_M 1
#endif
#ifndef QKV_F8_N
#define QKV_F8_N 1
#endif
#ifndef WO_F8
#define WO_F8 1
#endif
#define YS_F8 1
constexpr float F8_YS = 16.f;
constexpr float F8_DS = 32.f;
constexpr float F8_W1S = 32.f, F8_HS = 32.f, F8_W2S = 8.f, F8_AS = 8.f;
constexpr int F8_S1 = 0x7a7a7a7a, F8_S2 = 0x7c7c7c7c;
constexpr int NT_MAX = (4 * T_ALL) / 256 + NEXP;

enum { I_X = 0, I_C, I_CTX, I_CCTX, I_ADAW, I_ADAB, I_N1G, I_N2G, I_AWQKV, I_AWO, I_ASINK, I_MWIN, I_MBG, I_MHN, I_MWO, I_NWQKV, I_NWO, I_NRPB,
       I_RW, I_RB, I_EWIN, I_EBIN, I_EWOUT, I_EBOUT, I_FG };

constexpr size_t MiB = 1u << 20;
constexpr size_t WS_CTL = 0, CTL_BYTES = 1 * MiB;
constexpr size_t WS_MOD = 1 * MiB;
constexpr size_t WS_GWT = 1 * MiB + 768 * 1024;
constexpr size_t WS_RWT = 2 * MiB;
constexpr size_t WS_AWQKV = 4 * MiB;
constexpr size_t WS_AWO = WS_AWQKV + 6 * MiB;
constexpr size_t WS_MWIN = WS_AWO + 4 * MiB;
constexpr size_t WS_MWO = WS_MWIN + 6 * MiB;
constexpr size_t WS_NWQKV = WS_MWO + 2 * MiB;
constexpr size_t WS_NWO = WS_NWQKV + 6 * MiB;
constexpr size_t WS_EWIN = 32 * MiB;
constexpr size_t WS_EWOUT = WS_EWIN + 512 * MiB;
constexpr size_t WS_X = WS_EWOUT + 256 * MiB;
constexpr size_t WS_H = WS_X + 132 * MiB;
constexpr size_t WS_QKV = WS_H + 66 * MiB;
constexpr size_t WS_O = WS_QKV + 198 * MiB;
constexpr size_t WS_ACT = WS_O + 66 * MiB;
constexpr size_t WS_YS = WS_ACT + 280 * MiB;
constexpr size_t WS_SLOT = WS_YS + 264 * MiB;
constexpr size_t WS_GATE = WS_SLOT + 5 * MiB;
constexpr size_t WS_GB = WS_GATE + 5 * MiB;
constexpr size_t WS_HD = WS_GB + 3 * MiB;
constexpr size_t WS_H8 = WS_HD + 264 * MiB;
constexpr size_t WS_END = WS_H8 + 33 * MiB;
constexpr int CW_BAR = 4096;
constexpr int CW_CNT = 16384;

constexpr int LDS_BYTES = 147456;
constexpr int MISC_OFF = 131072;

#define XB_TMO      128
#define XB_XCNT(j)  (256  + 64 * (j))
#define XB_XSUB(j)  (1280 + 64 * (j))
#define XB_XGEN(j)  (2304 + 64 * (j))
#define XB_TOP      3328
#define XB_TOPGEN   3392
#define XCD_BAR_WORDS 3456
#define XB_SPIN_CAP (1u << 22)
__device__ __forceinline__ unsigned xb_ld(unsigned* p)              { return __hip_atomic_load(p, __ATOMIC_RELAXED, __HIP_MEMORY_SCOPE_AGENT); }
__device__ __forceinline__ unsigned xb_add(unsigned* p, unsigned v) { return __hip_atomic_fetch_add(p, v, __ATOMIC_RELAXED, __HIP_MEMORY_SCOPE_AGENT); }
__device__ __forceinline__ unsigned xb_xcc_id() { return (unsigned)__builtin_amdgcn_s_getreg((3 << 11) | 20) & 0xFu; }
#define XB_SPIN(cond, bar) do { unsigned _sp = 0; while (cond) { __builtin_amdgcn_s_sleep(1); \
    if ((++_sp & 255u) == 0u) { if (xb_ld(&(bar)[XB_TMO])) break; if (_sp > XB_SPIN_CAP) { atomicAdd(&(bar)[XB_TMO], 1u); break; } } } } while (0)
struct XcdBarrier { unsigned* bar; unsigned x; volatile LAS unsigned* st; };
__device__ __forceinline__ XcdBarrier xcd_barrier_post(unsigned* bar, volatile LAS unsigned* st) {
    XcdBarrier b; b.bar = bar; b.x = xb_xcc_id(); b.st = st;
    if (threadIdx.x == 0) (void)xb_add(&bar[XB_XCNT(b.x)], 1u);
    return b;
}
__device__ __forceinline__ void xcd_barrier_complete(unsigned* bar, unsigned x, unsigned& nloc, unsigned& nx) {
    const unsigned G = gridDim.x * gridDim.y * gridDim.z;
    unsigned sum, cnt, mine, sp = 0u;
    for (;;) {
        sum = 0u; cnt = 0u; mine = 0u;
#pragma unroll
        for (unsigned j = 0; j < 16; ++j) { const unsigned c = xb_ld(&bar[XB_XCNT(j)]); sum += c; cnt += (c > 0u) ? 1u : 0u; mine = (j == x) ? c : mine; }
        if (sum == G) break;
        __builtin_amdgcn_s_sleep(1);
        if ((++sp & 255u) == 0u) { if (xb_ld(&bar[XB_TMO])) break; if (sp > XB_SPIN_CAP) { atomicAdd(&bar[XB_TMO], 1u); break; } }
    }
    nloc = mine > 0u ? mine : 1u; nx = cnt > 0u ? cnt : 1u;
}
__device__ __forceinline__ void xcd_barrier(const XcdBarrier& b, int wave) {
    asm volatile("s_waitcnt vmcnt(0)" ::: "memory");
    __syncthreads();
    if (wave == 0 && __builtin_amdgcn_mbcnt_hi(~0u, __builtin_amdgcn_mbcnt_lo(~0u, 0u)) == 0u) {
        unsigned* bar = b.bar;
        __builtin_amdgcn_s_waitcnt(0);
        unsigned nloc = b.st[0], nx = b.st[1];
        if (nloc == 0u) { xcd_barrier_complete(bar, b.x, nloc, nx); b.st[0] = nloc; b.st[1] = nx; }
        const unsigned old = xb_add(&bar[XB_XSUB(b.x)], 1u);
        const unsigned gen = old / nloc;
        if (old + 1u == (gen + 1u) * nloc) {
            __builtin_amdgcn_fence(__ATOMIC_RELEASE, "agent");
            asm volatile("s_waitcnt vmcnt(0)" ::: "memory");
            const unsigned og = xb_add(&bar[XB_TOP], 1u);
            const unsigned tg = og / nx;
            if (og + 1u == (tg + 1u) * nx) xb_add(&bar[XB_TOPGEN], 1u);
            else XB_SPIN(xb_ld(&bar[XB_TOPGEN]) == tg, bar);
            __builtin_amdgcn_fence(__ATOMIC_ACQUIRE, "agent");
            xb_add(&bar[XB_XGEN(b.x)], 1u);
            asm volatile("s_waitcnt vmcnt(0)" ::: "memory");
        } else {
            XB_SPIN(xb_ld(&bar[XB_XGEN(b.x)]) == gen, bar);
            __builtin_amdgcn_fence(__ATOMIC_ACQUIRE, "agent");
            asm volatile("s_waitcnt vmcnt(0)" ::: "memory");
        }
    }
    __syncthreads();
}

__device__ __forceinline__ int lane_now() { int l = (int)__builtin_amdgcn_mbcnt_hi(~0u, __builtin_amdgcn_mbcnt_lo(~0u, 0u)); asm volatile("" : "+v"(l)); return l; }
#define TIDLANE const int lane = lane_now(); const int tid = F.wave * 64 + lane; (void)tid; (void)lane;

#define dpp_f(oldv, src, ctrl, rmask) __builtin_bit_cast(float, __builtin_amdgcn_update_dpp(__builtin_bit_cast(int, (float)(oldv)), __builtin_bit_cast(int, (float)(src)), ctrl, rmask, 0xf, false))
__device__ __forceinline__ float wave_scan_add(float v) {
    v += dpp_f(0.f, v, 0x111, 0xf); v += dpp_f(0.f, v, 0x112, 0xf); v += dpp_f(0.f, v, 0x114, 0xf); v += dpp_f(0.f, v, 0x118, 0xf);
    v += dpp_f(0.f, v, 0x142, 0xa); v += dpp_f(0.f, v, 0x143, 0xc); return v; }
__device__ __forceinline__ float wave_scan_max(float v) { const float NI = -3.0e38f;
    v = fmaxf(v, dpp_f(NI, v, 0x111, 0xf)); v = fmaxf(v, dpp_f(NI, v, 0x112, 0xf)); v = fmaxf(v, dpp_f(NI, v, 0x114, 0xf)); v = fmaxf(v, dpp_f(NI, v, 0x118, 0xf));
    v = fmaxf(v, dpp_f(NI, v, 0x142, 0xa)); v = fmaxf(v, dpp_f(NI, v, 0x143, 0xc)); return v; }

__device__ __forceinline__ float wave_sum(float v) {
    v = wave_scan_add(v); return __builtin_bit_cast(float, __builtin_amdgcn_readlane(__builtin_bit_cast(int, v), 63)); }
__device__ __forceinline__ float wave_max(float v) {
#pragma unroll
    for (int o = 1; o < 64; o <<= 1) v = fmaxf(v, __shfl_xor(v, o));
    return v;
}
__device__ __forceinline__ unsigned f2bf(float f) { unsigned u = __float_as_uint(f); return (u + 0x7fffu + ((u >> 16) & 1u)) >> 16; }
__device__ __forceinline__ unsigned pk2(float lo, float hi) { return f2bf(lo) | (f2bf(hi) << 16); }
__device__ __forceinline__ float bflo(unsigned w) { return __uint_as_float(w << 16); }
__device__ __forceinline__ float bfhi(unsigned w) { return __uint_as_float(w & 0xffff0000u); }
__device__ __forceinline__ float bf2f(bf16 b) { return __uint_as_float(((unsigned)b) << 16); }
__device__ __forceinline__ unsigned cvt_pk_bf16(float lo, float hi) { unsigned r; asm volatile("v_cvt_pk_bf16_f32 %0, %1, %2" : "=v"(r) : "v"(lo), "v"(hi)); return r; }
__device__ __forceinline__ float sel_mask(float a, float b, unsigned long long m) { float r; asm("v_cndmask_b32 %0, %1, %2, %3" : "=v"(r) : "v"(a), "v"(b), "s"(m)); return r; }
#define UPMASK(st) ((st) == 32 ? 0xFFFFFFFF00000000ull : (st) == 16 ? 0xFFFF0000FFFF0000ull : (st) == 8 ? 0xFF00FF00FF00FF00ull : (st) == 4 ? 0xF0F0F0F0F0F0F0F0ull : (st) == 2 ? 0xCCCCCCCCCCCCCCCCull : 0xAAAAAAAAAAAAAAAAull)
__device__ __forceinline__ float clamp448(float x) { return fminf(fmaxf(x, -448.f), 448.f); }
__device__ __forceinline__ unsigned pack4_fp8(float a, float b, float c, float d) { int r = 0; r = __builtin_amdgcn_cvt_pk_fp8_f32(clamp448(a), clamp448(b), r, false); r = __builtin_amdgcn_cvt_pk_fp8_f32(clamp448(c), clamp448(d), r, true); return (unsigned)r; }
__device__ __forceinline__ unsigned pack4_fp8_nc(float a, float b, float c, float d) { int r = 0; r = __builtin_amdgcn_cvt_pk_fp8_f32(a, b, r, false); r = __builtin_amdgcn_cvt_pk_fp8_f32(c, d, r, true); return (unsigned)r; }
__device__ __forceinline__ float ffma_s(float a, float b, float c) { float r; asm("v_fma_f32 %0, %1, %2, %3" : "=v"(r) : "v"(a), "v"(b), "v"(c)); return r; }
__device__ __forceinline__ float fmul_s(float a, float b) { float r; asm("v_mul_f32_e32 %0, %1, %2" : "=v"(r) : "v"(a), "v"(b)); return r; }
__device__ __forceinline__ float fadd_s(float a, float b) { float r; asm("v_add_f32_e32 %0, %1, %2" : "=v"(r) : "v"(a), "v"(b)); return r; }
__device__ __forceinline__ f32x4 ld4bf(const bf16* p) { const v2u w = *(const v2u*)p; return (f32x4){bflo(w.x), bfhi(w.x), bflo(w.y), bfhi(w.y)}; }
__device__ __forceinline__ void st4bf(bf16* p, f32x4 v) { v2u w; w.x = cvt_pk_bf16(v[0], v[1]); w.y = cvt_pk_bf16(v[2], v[3]); *(v2u*)p = w; }
__device__ __forceinline__ float fmin_s(float a, float b) { float r; asm("v_min_f32_e32 %0, %1, %2" : "=v"(r) : "v"(a), "v"(b)); return r; }
__device__ __forceinline__ float fclamp_s(float x, float lim) { float r; asm("v_med3_f32 %0, %1, -%2, %2" : "=v"(r) : "v"(x), "s"(lim)); return r; }
__device__ __forceinline__ float fmax3_s(float a, float b, float c) { float r; asm("v_max3_f32 %0, %1, %2, %3" : "=v"(r) : "v"(a), "v"(b), "v"(c)); return r; }
__device__ __forceinline__ float fmed3_s(float a, float b, float c) { float r; asm("v_med3_f32 %0, %1, %2, %3" : "=v"(r) : "v"(a), "v"(b), "v"(c)); return r; }
__device__ __forceinline__ float sigmoidf_(float x) { return __builtin_amdgcn_rcpf(1.f + __builtin_amdgcn_exp2f(-1.4426950408889634f * x)); }

namespace pg8 {
constexpr int BM = 256, BK = 64, HALF = 128, HTB = HALF * BK * 2, STAGE_BYTES = 8 * HTB;
__device__ __forceinline__ int lds_byte(int r, int c) { const int st = (r >> 4) * 2 + (c >> 5), rr = r & 15, cc = c & 31, ob = rr * 64 + cc * 2; return st * 1024 + (ob ^ (((ob >> 9) & 1) << 5)); }
__device__ __forceinline__ void stage_rc(int b, int& R, int& C) { const int st = b / 1024, sb = b % 1024, swz = sb ^ (((sb >> 9) & 1) << 5); R = (st >> 1) * 16 + swz / 64; C = (st & 1) * 32 + (swz % 64) / 2; }
__device__ __forceinline__ int perm32(int rho) { const int n = rho >> 4, i = rho & 15; return 8 * (i >> 2) + 4 * n + (i & 3); }

struct Unit { int pm, pn, e, nvalid, rowbase; };

struct DenseOrder {
    static constexpr bool GATHER = false; int nN, nunits, G, c; const char* Bt; size_t tstep;
    __device__ __forceinline__ bool next(int i, Unit& u, int = 0) const { const int L = i * G + c; if (L >= nunits) return false; u.pm = L / nN; u.pn = L - u.pm * nN; u.e = 0; u.nvalid = 256; u.rowbase = u.pm * 256; return true; }
    __device__ __forceinline__ unsigned row_off(const Unit& u, int r, int rb) const { return (unsigned)(u.pm * 256 + r) * (unsigned)rb; }
    __device__ __forceinline__ const char* bptr(const Unit& u) const { return Bt + (size_t)u.pn * tstep; }
};
template <bool GATHER_> struct MoeOrder {
    static constexpr bool GATHER = GATHER_; int nN, G, c; const char* Bt; size_t tstep, estep; const LAS int* tstart; const LAS int* cnt; const int* slot_of;
    __device__ __forceinline__ bool next(int i, Unit& u, int ehint = 0) const {
        const int L = i * G + c; const int rt = L / nN; const int nt = __builtin_amdgcn_readfirstlane(tstart[NEXP]);
        if (rt >= nt) return false;
        int e = ehint; while (__builtin_amdgcn_readfirstlane(tstart[e + 1]) <= rt) ++e;
        const int j = rt - __builtin_amdgcn_readfirstlane(tstart[e]); const int ce = __builtin_amdgcn_readfirstlane(cnt[e]);
        u.pm = rt; u.pn = L - rt * nN; u.e = e; u.nvalid = (ce - j * 256) < 256 ? (ce - j * 256) : 256; u.rowbase = e * T_ALL + j * 256; return true;
    }
    __device__ __forceinline__ unsigned row_off(const Unit& u, int r, int rb) const {
        if (GATHER) { const int v = slot_of[u.rowbase + r]; const int tok = r < u.nvalid ? v >> 2 : 0; return (unsigned)tok * (unsigned)rb; }
        return (unsigned)(u.pm * 256 + r) * (unsigned)rb;
    }
    __device__ __forceinline__ const char* bptr(const Unit& u) const { return Bt + (size_t)u.e * estep + (size_t)u.pn * tstep; }
};

typedef const f32x4 (&AccRef)[2][2][4][2];
typedef f32x4 (&AccMut)[2][2][4][2];
constexpr int TAB_OFF = MISC_OFF + 7168, TAB_BYTES = 3072;
__device__ __forceinline__ void dma16(const char* sbase, unsigned voff, unsigned lds_dst) { unsigned keep;
    asm volatile("s_mov_b32 %0, m0\n\ts_mov_b32 m0, %3\n\ts_nop 0\n\tglobal_load_lds_dwordx4 %2, %1\n\ts_mov_b32 m0, %0" : "=&s"(keep) : "s"(sbase), "v"(voff), "s"(lds_dst) : "memory"); }

struct EpiBf16 {
    static constexpr int SW = 0x7a7a7a7a, SA = 0x7a7a7a7a; static constexpr bool PERM = true, HAS_TAB = false; bf16* O; int ldc;
    __device__ __forceinline__ void operator()(AccRef acc, const Unit& u, const LAS unsigned char*, int wr, int wc, int fr, int fq) const {
        const int row0 = u.pm * BM + wr * 64 + fr, col0 = u.pn * BM + wc * 32 + 8 * fq;
#pragma unroll
        for (int ai = 0; ai < 2; ++ai)
#pragma unroll
            for (int m = 0; m < 4; ++m) { bf16* rowp = O + (size_t)(row0 + ai * HALF + m * 16) * ldc + col0;
#pragma unroll
                for (int bj = 0; bj < 2; ++bj) { const f32x4 v0 = acc[ai][bj][m][0], v1 = acc[ai][bj][m][1];
                    v4u w; w.x = cvt_pk_bf16(v0[0], v0[1]); w.y = cvt_pk_bf16(v0[2], v0[3]); w.z = cvt_pk_bf16(v1[0], v1[1]); w.w = cvt_pk_bf16(v1[2], v1[3]);
                    *(v4u*)(rowp + bj * HALF) = w; } }
    }
};
struct EpiQkvA {
    static constexpr int SW = 0x7a7a7a7a, SA = 0x7a7a7a7a; static constexpr bool PERM = false, HAS_TAB = false; bf16* O;
    __device__ __forceinline__ void operator()(AccRef acc, const Unit& u, const LAS unsigned char*, int wr, int wc, int fr, int fq) const {
        const int row0 = u.pm * BM + wr * 64 + fr, col0 = u.pn * BM + wc * 32 + 4 * fq;
        const bool rope = (u.pm < T_LAT / 256) && (u.pn <= 4);
        float fq4[4];
#pragma unroll
        for (int i = 0; i < 4; ++i) fq4[i] = exp2f(-(float)(4 * fq + i) * (13.287712379549449f / 16.f));
        const int odd = fq & 1;
#pragma unroll
        for (int ai = 0; ai < 2; ++ai)
#pragma unroll
            for (int mp = 0; mp < 2; ++mp) { v2u pa[2][2], pb[2][2];
#pragma unroll
                for (int mm = 0; mm < 2; ++mm) { const int m = 2 * mp + mm; const int row = row0 + ai * HALF + m * 16; const int s = row & (SEQ - 1); const float pos = (float)((wc & 1) ? (s & 63) : (s >> 6));
                    float sn[4], cs[4];
#pragma unroll
                    for (int i = 0; i < 4; ++i) { const float rev = __builtin_amdgcn_fractf(pos * fq4[i] * 0.15915494309189535f); sn[i] = rope ? __builtin_amdgcn_sinf(rev) : 0.f; cs[i] = rope ? __builtin_amdgcn_cosf(rev) : 1.f; }
#pragma unroll
                    for (int bj = 0; bj < 2; ++bj) { const f32x4 u1 = acc[ai][bj][m][0], u2 = acc[ai][bj][m][1]; float o1[4], o2[4];
#pragma unroll
                        for (int i = 0; i < 4; ++i) { o1[i] = u1[i] * cs[i] - u2[i] * sn[i]; o2[i] = u1[i] * sn[i] + u2[i] * cs[i]; }
                        pa[mm][bj].x = cvt_pk_bf16(o1[0], o1[1]); pa[mm][bj].y = cvt_pk_bf16(o1[2], o1[3]); pb[mm][bj].x = cvt_pk_bf16(o2[0], o2[1]); pb[mm][bj].y = cvt_pk_bf16(o2[2], o2[3]); } }
                bf16* rowp = O + (size_t)(row0 + ai * HALF + (2 * mp + odd) * 16) * 1536 + col0 - 4 * odd;
#pragma unroll
                for (int bj = 0; bj < 2; ++bj) {
                    const auto a0 = __builtin_amdgcn_permlane16_swap(pa[0][bj].x, pa[1][bj].x, false, false); const auto a1 = __builtin_amdgcn_permlane16_swap(pa[0][bj].y, pa[1][bj].y, false, false);
                    const auto b0 = __builtin_amdgcn_permlane16_swap(pb[0][bj].x, pb[1][bj].x, false, false); const auto b1 = __builtin_amdgcn_permlane16_swap(pb[0][bj].y, pb[1][bj].y, false, false);
                    *(v4u*)(rowp + bj * HALF) = (v4u){(unsigned)a0[0], (unsigned)a1[0], (unsigned)a0[1], (unsigned)a1[1]};
                    *(v4u*)(rowp + bj * HALF + 16) = (v4u){(unsigned)b0[0], (unsigned)b1[0], (unsigned)b0[1], (unsigned)b1[1]}; } }
    }
};
struct EpiRes {
    static constexpr int SW = 0x7a7a7a7a, SA = 0x7a7a7a7a; static constexpr bool PERM = true, HAS_TAB = false; bf16* X; const float* gmod; float rs;
    __device__ __forceinline__ void operator()(AccRef acc, const Unit& u, const LAS unsigned char*, int wr, int wc, int fr, int fq) const {
        const int row0 = u.pm * BM + wr * 64 + fr, col0 = u.pn * BM + wc * 32 + 8 * fq;
        const int bidx = u.pm < T_LAT / 256 ? u.pm / (SEQ / 256) : 4; const float* g = gmod + bidx * 6144;
        f32x4 gv[2][2];
#pragma unroll
        for (int bj = 0; bj < 2; ++bj)
#pragma unroll
            for (int n = 0; n < 2; ++n) gv[bj][n] = *(const f32x4*)(g + col0 + bj * HALF + 4 * n) * rs;
        v4u xin[2][4][2];
#pragma unroll
        for (int ai = 0; ai < 2; ++ai)
#pragma unroll
            for (int m = 0; m < 4; ++m)
#pragma unroll
                for (int bj = 0; bj < 2; ++bj) xin[ai][m][bj] = *(const v4u*)(X + (size_t)(row0 + ai * HALF + m * 16) * D + col0 + bj * HALF);
        __builtin_amdgcn_sched_barrier(0);
#pragma unroll
        for (int ai = 0; ai < 2; ++ai)
#pragma unroll
            for (int m = 0; m < 4; ++m) { bf16* rowp = X + (size_t)(row0 + ai * HALF + m * 16) * D + col0;
#pragma unroll
                for (int bj = 0; bj < 2; ++bj) { const v4u xw = xin[ai][m][bj]; const unsigned xs[4] = {xw.x, xw.y, xw.z, xw.w}; float y[8];
#pragma unroll
                    for (int q = 0; q < 4; ++q) { const int n = q >> 1, j = 2 * (q & 1);
                        y[2 * q] = ffma_s(gv[bj][n][j], acc[ai][bj][m][n][j], bflo(xs[q])); y[2 * q + 1] = ffma_s(gv[bj][n][j + 1], acc[ai][bj][m][n][j + 1], bfhi(xs[q])); }
                    v4u w; w.x = cvt_pk_bf16(y[0], y[1]); w.y = cvt_pk_bf16(y[2], y[3]); w.z = cvt_pk_bf16(y[4], y[5]); w.w = cvt_pk_bf16(y[6], y[7]);
                    *(v4u*)(rowp + bj * HALF) = w; } }
    }
};
struct EpiSwiglu {
    static constexpr bool PERM = true, HAS_TAB = true; static constexpr int SW = F8_S1, SA = F8_S1; unsigned char* ACT; const float* b_in; const int* slot_of;
    __device__ __forceinline__ void stage(const Unit& u, unsigned lds_slot, int wid, int lane) const { if (wid == 0) dma16((const char*)(b_in + (size_t)u.e * 2048 + u.pn * 256), (unsigned)lane * 16u, lds_slot);
        if (wid == 1) dma16((const char*)(slot_of + u.rowbase), (unsigned)lane * 16u, lds_slot + 1024u); }
    __device__ __forceinline__ void init(f32x4 (&ci)[2][2], const LAS unsigned char* tab, int wc, int fq) const {
        const LAS f32x4* bp = (const LAS f32x4*)(tab + (wc * 32 + 8 * fq) * 8); f32x4 bb[4];
#pragma unroll
        for (int i = 0; i < 4; ++i) bb[i] = bp[i];
#pragma unroll
        for (int n = 0; n < 2; ++n) { ci[0][n] = (f32x4){bb[2 * n][0], bb[2 * n][2], bb[2 * n + 1][0], bb[2 * n + 1][2]}; ci[1][n] = (f32x4){bb[2 * n][1], bb[2 * n][3], bb[2 * n + 1][1], bb[2 * n + 1][3]}; }
    }
    __device__ __forceinline__ void operator()(AccRef acc, const Unit& u, const LAS unsigned char*, int wr, int wc, int fr, int fq) const {
        const int row0 = u.pm * BM + wr * 64 + fr, o0 = u.pn * 128 + wc * 32 + 8 * fq;
        const int odd = fq & 1;
#pragma unroll
        for (int ai = 0; ai < 2; ++ai)
#pragma unroll
            for (int mp = 0; mp < 2; ++mp) { v2u w[2];
#pragma unroll
                for (int mm = 0; mm < 2; ++mm) { const int m = 2 * mp + mm; float o[8];
#pragma unroll
                    for (int n = 0; n < 2; ++n)
#pragma unroll
                        for (int i = 0; i < 4; ++i) { const int j = 4 * n + i; float g = acc[ai][0][m][n][i], up = acc[ai][1][m][n][i];
                            g = fmin_s(g, 7.f); up = ffma_s(fmed3_s(up, -7.f, 7.f), F8_AS, F8_AS); o[j] = (g * up) * __builtin_amdgcn_rcpf(1.f + __builtin_amdgcn_exp2f((-1.702f * 1.4426950408889634f) * g)); }
                    w[mm].x = pack4_fp8_nc(o[0], o[1], o[2], o[3]); w[mm].y = pack4_fp8_nc(o[4], o[5], o[6], o[7]); }
                const auto r0 = __builtin_amdgcn_permlane16_swap(w[0].x, w[1].x, false, false); const auto r1 = __builtin_amdgcn_permlane16_swap(w[0].y, w[1].y, false, false);
                const v4u q = {(unsigned)r0[0], (unsigned)r1[0], (unsigned)r0[1], (unsigned)r1[1]};
                *(v4u*)(ACT + (size_t)(row0 + ai * HALF + (2 * mp + odd) * 16) * DFF + o0 - 8 * odd) = q; }
    }
};
struct EpiMoe2 {
    static constexpr bool PERM = true, HAS_TAB = true; static constexpr int SW = F8_S2, SA = F8_S2; bf16* YS; const float* b_out; const int* slot_of; const float* gate_of;
    __device__ __forceinline__ void stage(const Unit& u, unsigned lds_slot, int wid, int lane) const {
        if (wid == 0) dma16((const char*)(b_out + (size_t)u.e * D + u.pn * 256), (unsigned)lane * 16u, lds_slot);
        if (wid == 1) dma16((const char*)(slot_of + u.rowbase), (unsigned)lane * 16u, lds_slot + 1024u);
        if (wid == 2) dma16((const char*)(gate_of + u.rowbase), (unsigned)lane * 16u, lds_slot + 2048u); }
    __device__ __forceinline__ void init(f32x4 (&ci)[2][2], const LAS unsigned char* tab, int wc, int fq) const {
#pragma unroll
        for (int bj = 0; bj < 2; ++bj)
#pragma unroll
            for (int n = 0; n < 2; ++n) ci[bj][n] = *(const LAS f32x4*)(tab + (bj * HALF + wc * 32 + 8 * fq + 4 * n) * 4);
    }
    __device__ __forceinline__ void operator()(AccRef acc, const Unit& u, const LAS unsigned char* tab, int wr, int wc, int fr, int fq) const {
        const int r0 = wr * 64 + fr, col0 = u.pn * BM + wc * 32 + 8 * fq;
        int slot[8]; float gt[8];
#pragma unroll
        for (int i = 0; i < 8; ++i) { const int r = r0 + (i >> 2) * HALF + (i & 3) * 16; const int sl = *(const LAS int*)(tab + 1024 + r * 4); gt[i] = *(const LAS float*)(tab + 2048 + r * 4); slot[i] = r < u.nvalid ? sl : -1; }
#if YS_F8
        {
            const int odd = fq & 1;
#pragma unroll
            for (int ai = 0; ai < 2; ++ai)
#pragma unroll
                for (int mp = 0; mp < 2; ++mp) { const int ra = r0 + ai * HALF + 2 * mp * 16, rt = ra + 16 * odd;
                    const float ga = *(const LAS float*)(tab + 2048 + ra * 4) * F8_YS, gb = *(const LAS float*)(tab + 2048 + (ra + 16) * 4) * F8_YS;
                    const int sl = *(const LAS int*)(tab + 1024 + rt * 4); const int st = rt < u.nvalid ? sl : -1;
                    unsigned char* rowp = (unsigned char*)YS + (size_t)(st >= 0 ? st : 0) * D + col0 - 8 * odd;
#pragma unroll
                    for (int bj = 0; bj < 2; ++bj) { v2u w[2];
#pragma unroll
                        for (int mm = 0; mm < 2; ++mm) { const int m = 2 * mp + mm; const float g = mm ? gb : ga; f32x4 v0, v1;
#pragma unroll
                            for (int j = 0; j < 4; ++j) { v0[j] = fclamp_s(fmul_s(acc[ai][bj][m][0][j], g), 448.f); v1[j] = fclamp_s(fmul_s(acc[ai][bj][m][1][j], g), 448.f); }
                            w[mm].x = pack4_fp8_nc(v0[0], v0[1], v0[2], v0[3]); w[mm].y = pack4_fp8_nc(v1[0], v1[1], v1[2], v1[3]); }
                        const auto r0 = __builtin_amdgcn_permlane16_swap(w[0].x, w[1].x, false, false); const auto r1 = __builtin_amdgcn_permlane16_swap(w[0].y, w[1].y, false, false);
                        if (st >= 0) *(v4u*)(rowp + bj * HALF) = (v4u){(unsigned)r0[0], (unsigned)r1[0], (unsigned)r0[1], (unsigned)r1[1]}; } }
            return;
        }
#endif
#pragma unroll
        for (int ai = 0; ai < 2; ++ai)
#pragma unroll
            for (int m = 0; m < 4; ++m) { const int i = ai * 4 + m;
                if (slot[i] >= 0) {
#if YS_F8
                    const float g = gt[i] * F8_YS; unsigned char* rowp = (unsigned char*)YS + (size_t)slot[i] * D + col0;
#pragma unroll
                    for (int bj = 0; bj < 2; ++bj) { f32x4 v0, v1;
#pragma unroll
                        for (int j = 0; j < 4; ++j) { v0[j] = fclamp_s(fmul_s(acc[ai][bj][m][0][j], g), 448.f); v1[j] = fclamp_s(fmul_s(acc[ai][bj][m][1][j], g), 448.f); }
                        v2u w; w.x = pack4_fp8_nc(v0[0], v0[1], v0[2], v0[3]); w.y = pack4_fp8_nc(v1[0], v1[1], v1[2], v1[3]);
                        *(v2u*)(rowp + bj * HALF) = w; }
#else
                    const float g = gt[i]; bf16* rowp = YS + (size_t)slot[i] * D + col0;
#pragma unroll
                    for (int bj = 0; bj < 2; ++bj) { f32x4 v0, v1;
#pragma unroll
                        for (int j = 0; j < 4; ++j) { v0[j] = fmul_s(acc[ai][bj][m][0][j], g); v1[j] = fmul_s(acc[ai][bj][m][1][j], g); }
                        v4u w; w.x = cvt_pk_bf16(v0[0], v0[1]); w.y = cvt_pk_bf16(v0[2], v0[3]); w.z = cvt_pk_bf16(v1[0], v1[1]); w.w = cvt_pk_bf16(v1[2], v1[3]);
                        *(v4u*)(rowp + bj * HALF) = w; }
#endif
                } }
    }
};

template <class Epi, class Sched, bool F8 = false>
__device__ __forceinline__ void gemm_phase(LAS unsigned char* lds, const char* A, const int K, const Sched& S, const Epi& E, const int wid) {
    const int lane = lane_now(), tid = wid * 64 + lane, wr = wid >> 2, wc = wid & 3;
    constexpr int ES = F8 ? 1 : 2; const int nt = (K * ES) / (BK * 2); const int rowb = K * ES;
    constexpr bool GA = Sched::GATHER;
    int R0, C0; stage_rc(tid * 16, R0, C0);
    const int Rb0 = Epi::PERM ? ((R0 & ~31) + perm32(R0 & 31)) : R0;
    const unsigned voffB0 = (unsigned)(Rb0 * rowb + C0 * 2), voffA0 = (unsigned)(R0 * rowb + C0 * 2);
    const size_t kstep = (size_t)(BK * 2);
    const size_t r64 = (size_t)64 * rowb;
    const unsigned ldsw = (unsigned)wid * 1024u;
    const unsigned ldsbase = (unsigned)(uintptr_t)lds + ldsw;
    const int aoff = lds_byte(wr * 64 + (lane & 15), (lane >> 4) * 8), boff = lds_byte(wc * 32 + (lane & 15), (lane >> 4) * 8);
#define PG8_SA(b, h) (((b) * 2 + (h)) * HTB)
#define PG8_SB(b, h) ((4 + (b) * 2 + (h)) * HTB)
#define PG8_DMA(bufoff, gptr, voff, i) dma16((const char*)(gptr), (voff), ldsbase + (unsigned)((bufoff) + (i) * 8192))
#define PG8_STAGEB(bufoff, gbase, h) do { PG8_DMA(bufoff, (gbase) + (size_t)(h) * 2 * r64, voffB0, 0); PG8_DMA(bufoff, (gbase) + (size_t)(h) * 2 * r64 + r64, voffB0, 1); } while (0)
#define PG8_STAGEA(bufoff, gbase, h, vv) do { if constexpr (GA) { PG8_DMA(bufoff, gbase, vv[h][0], 0); PG8_DMA(bufoff, gbase, vv[h][1], 1); } \
        else { PG8_DMA(bufoff, (gbase) + (size_t)(h) * 2 * r64, voffA0, 0); PG8_DMA(bufoff, (gbase) + (size_t)(h) * 2 * r64 + r64, voffA0, 1); } } while (0)
#define PG8_LDA(dst, b, h) do { _Pragma("unroll") for (int m = 0; m < 4; ++m) _Pragma("unroll") for (int k = 0; k < 2; ++k) dst[m][k] = *(const LAS bf16x8*)(lds + PG8_SA(b, h) + aoff + m * 2048 + k * 1024); } while (0)
#define PG8_LDB(dst, b, h) do { _Pragma("unroll") for (int n = 0; n < 2; ++n) _Pragma("unroll") for (int k = 0; k < 2; ++k) dst[n][k] = *(const LAS bf16x8*)(lds + PG8_SB(b, h) + boff + n * 2048 + k * 1024); } while (0)
#define PG8_MMA(ai, bj, At, Bt, FIRST) do { __builtin_amdgcn_s_setprio(1); \
        if constexpr (F8) { _Pragma("unroll") for (int m = 0; m < 4; ++m) _Pragma("unroll") for (int n = 0; n < 2; ++n) \
            acc[ai][bj][m][n] = __builtin_amdgcn_mfma_scale_f32_16x16x128_f8f6f4(__builtin_shufflevector(__builtin_bit_cast(v4i, Bt[n][0]), __builtin_bit_cast(v4i, Bt[n][1]), 0, 1, 2, 3, 4, 5, 6, 7), \
                __builtin_shufflevector(__builtin_bit_cast(v4i, At[m][0]), __builtin_bit_cast(v4i, At[m][1]), 0, 1, 2, 3, 4, 5, 6, 7), (FIRST) ? ci[bj][n] : acc[ai][bj][m][n], 0, 0, 0, Epi::SW, 0, Epi::SA); } \
        else { _Pragma("unroll") for (int m = 0; m < 4; ++m) _Pragma("unroll") for (int n = 0; n < 2; ++n) _Pragma("unroll") for (int k = 0; k < 2; ++k) \
            acc[ai][bj][m][n] = __builtin_amdgcn_mfma_f32_16x16x32_bf16(Bt[n][k], At[m][k], ((FIRST) && k == 0) ? ci[bj][n] : acc[ai][bj][m][n], 0, 0, 0); } __builtin_amdgcn_s_setprio(0); } while (0)
#define PG8_WAIT_V(n) asm volatile("s_waitcnt vmcnt(" #n ")" ::: "memory")
#define PG8_WAIT_L(n) asm volatile("s_waitcnt lgkmcnt(" #n ")" ::: "memory")
#define PG8_BAR __builtin_amdgcn_s_barrier()
#define PG8_SCHED __builtin_amdgcn_sched_barrier(0)
#define PG8_LOADV(u, v) do { if constexpr (GA) { _Pragma("unroll") for (int _h = 0; _h < 2; ++_h) _Pragma("unroll") for (int _i = 0; _i < 2; ++_i) v[_h][_i] = S.row_off(u, _h * HALF + _i * 64 + R0, rowb) + (unsigned)(C0 * 2); } } while (0)
#define PG8_ABASE(u) (GA ? A : A + (size_t)(u).pm * 4 * r64)
    Unit cur, nxt; int ui = 0;
    if (!S.next(0, cur)) return;
    const LAS unsigned char* tab0 = lds + (TAB_OFF - 0);
    if constexpr (Epi::HAS_TAB) E.stage(cur, (unsigned)(uintptr_t)tab0, wid, lane);
    f32x4 acc[2][2][4][2];
    f32x4 ci[2][2] = {{{0.f, 0.f, 0.f, 0.f}, {0.f, 0.f, 0.f, 0.f}}, {{0.f, 0.f, 0.f, 0.f}, {0.f, 0.f, 0.f, 0.f}}};
#define PG8_FILL() do { _Pragma("unroll") for (int a_ = 0; a_ < 2; ++a_) _Pragma("unroll") for (int b_ = 0; b_ < 2; ++b_) _Pragma("unroll") for (int m_ = 0; m_ < 4; ++m_) _Pragma("unroll") for (int n_ = 0; n_ < 2; ++n_) acc[a_][b_][m_][n_] = ci[b_][n_]; } while (0)
    bf16x8 At[4][2], B0[2][2], B1[2][2];
    unsigned cv[2][2] = {{0u, 0u}, {0u, 0u}};
    PG8_LOADV(cur, cv);
    const char* cA = PG8_ABASE(cur); const char* cB = S.bptr(cur);
    PG8_STAGEB(PG8_SB(0, 0), cB, 0); PG8_STAGEB(PG8_SB(0, 1), cB, 1); PG8_STAGEA(PG8_SA(0, 0), cA, 0, cv); PG8_STAGEA(PG8_SA(0, 1), cA, 1, cv);
    if (wr == 1) PG8_BAR;
    PG8_WAIT_V(2); PG8_BAR;
    PG8_STAGEB(PG8_SB(1, 0), cB + kstep, 0); PG8_STAGEA(PG8_SA(1, 0), cA + kstep, 0, cv); PG8_STAGEB(PG8_SB(1, 1), cB + kstep, 1);
    PG8_WAIT_V(6); PG8_BAR;
    if constexpr (Epi::HAS_TAB) { E.init(ci, tab0, wc, lane >> 4); PG8_FILL(); }
    for (;;) {
        const bool has_next = S.next(ui + 1, nxt, cur.e);
        if constexpr (Epi::HAS_TAB) { if (has_next) E.stage(nxt, (unsigned)(uintptr_t)tab0 + (unsigned)(((ui + 1) % 3) * TAB_BYTES), wid, lane); }
        const char* nA = has_next ? PG8_ABASE(nxt) : cA; const char* nB = has_next ? S.bptr(nxt) : cB;
#define PG8_ITER(FIRST_) do { \
            const bool last = (t == nt - 2); \
            const char* a1 = cA + (size_t)(t + 1) * kstep; \
            const char* a2 = last ? nA : cA + (size_t)(t + 2) * kstep; const char* b2 = last ? nB : cB + (size_t)(t + 2) * kstep; \
            const char* a3 = a2 + kstep; const char* b3 = b2 + kstep; \
              \
            PG8_LDB(B0, 0, 0); PG8_LDB(B1, 0, 1); PG8_SCHED; PG8_LDA(At, 0, 0); PG8_STAGEA(PG8_SA(1, 1), a1, 1, cv); \
            if constexpr (GA) { if (last && has_next) {            \
                const LAS int* st_ = (const LAS int*)(tab0 + ((ui + 1) % 3) * TAB_BYTES + 1024);     \
_Pragma("unroll") \
                for (int h = 0; h < 2; ++h) \
_Pragma("unroll") \
                    for (int i = 0; i < 2; ++i) { const int r_ = h * HALF + i * 64 + R0; const int v_ = st_[r_]; cv[h][i] = (unsigned)(r_ < nxt.nvalid ? v_ >> 2 : 0) * (unsigned)rowb + (unsigned)(C0 * 2); } } } \
            PG8_WAIT_V(8); PG8_WAIT_L(0); PG8_BAR; PG8_MMA(0, 0, At, B0, FIRST_); PG8_MMA(0, 1, At, B1, FIRST_); PG8_BAR; PG8_SCHED; \
              \
            PG8_LDA(At, 0, 1); PG8_STAGEB(PG8_SB(0, 0), b2, 0); PG8_STAGEB(PG8_SB(0, 1), b2, 1); PG8_STAGEA(PG8_SA(0, 0), a2, 0, cv); \
            PG8_WAIT_V(8); PG8_WAIT_L(0); PG8_BAR; PG8_MMA(1, 0, At, B0, FIRST_); PG8_MMA(1, 1, At, B1, FIRST_); PG8_BAR; PG8_SCHED; \
              \
            PG8_LDB(B0, 1, 0); PG8_LDB(B1, 1, 1); PG8_SCHED; PG8_LDA(At, 1, 0); PG8_STAGEA(PG8_SA(0, 1), a2, 1, cv); \
            PG8_WAIT_V(8); PG8_WAIT_L(0); PG8_BAR; PG8_MMA(0, 0, At, B0, false); PG8_MMA(0, 1, At, B1, false); PG8_BAR; PG8_SCHED; \
              \
            PG8_LDA(At, 1, 1); PG8_STAGEB(PG8_SB(1, 0), b3, 0); PG8_STAGEB(PG8_SB(1, 1), b3, 1); PG8_STAGEA(PG8_SA(1, 0), a3, 0, cv); \
            PG8_WAIT_V(8); PG8_WAIT_L(0); PG8_BAR; PG8_MMA(1, 0, At, B0, false); PG8_MMA(1, 1, At, B1, false); PG8_BAR; PG8_SCHED; \
        } while (0)
        if constexpr (!Epi::HAS_TAB) {
            { const int t = 0; PG8_ITER(true); }
#pragma unroll 1
            for (int t = 2; t < nt; t += 2) PG8_ITER(false);
        } else {
#pragma unroll 1
            for (int t = 0; t < nt; t += 2) PG8_ITER(false);
        }
#undef PG8_ITER
        if (wr == 0) PG8_BAR;
        { const int l_ = lane_now(); E(acc, cur, tab0 + (ui % 3) * TAB_BYTES, wr, wc, l_ & 15, l_ >> 4); }
        if (!has_next) break;
        cur = nxt; cA = nA; cB = nB; ++ui;
        if constexpr (Epi::HAS_TAB) { const int l_ = lane_now(); E.init(ci, tab0 + (ui % 3) * TAB_BYTES, wc, l_ >> 4); PG8_FILL(); }
        if (wr == 1) PG8_BAR;
    }
    PG8_WAIT_V(0);
    PG8_BAR;
#undef PG8_SA
#undef PG8_SB
#undef PG8_DMA
#undef PG8_STAGEA
#undef PG8_STAGEB
#undef PG8_LDA
#undef PG8_LDB
#undef PG8_MMA
#undef PG8_WAIT_V
#undef PG8_WAIT_L
#undef PG8_BAR
#undef PG8_SCHED
#undef PG8_LOADV
#undef PG8_ABASE
#undef PG8_FILL
}
}

struct Args { const float* in[25]; float* out; unsigned char* ws; int ph_lo, ph_hi, stop_layers, fin_combine; };

struct Frame {
    LAS unsigned char* lds; volatile LAS unsigned* MISC; unsigned* ctl;
    int wave, G, vcu, gw, NGW;
    const float* in[25]; unsigned char* ws;
    float* mod; bf16* X; bf16* H; bf16* QKV; bf16* O; bf16* ACT; bf16* YS; int* slot_of; float* gate_of; float* GB; bf16* HD;
};

template <int MODE  , bool F8 = false>
__device__ __forceinline__ void transpose_item(const float* W, int K, int N, int col0, int nblk, void* WTv, LAS float* scr, int item, int lane, float F8_WS = 1.f) {
    const int kb = item / nblk, nb = item % nblk, k0 = 64 * kb, n0 = 32 * nb;
#pragma unroll
    for (int i = 0; i < 32; ++i) { const int kk = 2 * i + (lane >> 5); scr[kk * 33 + (lane & 31)] = W[(size_t)(k0 + kk) * N + col0 + n0 + (lane & 31)]; }
    asm volatile("s_waitcnt lgkmcnt(0)" ::: "memory");
    const int c = lane & 7;
#pragma unroll
    for (int j = 0; j < 4; ++j) { const int n = (lane >> 3) + 8 * j; const LAS float* s = scr + (8 * c) * 33 + n;
        const int nn = n0 + n; int row = nn;
        if (MODE == 1) { const int oo = nn >> 1, bj = nn & 1; row = (oo >> 7) * 256 + bj * 128 + (oo & 127); }
        if (F8) { v2u o; o.x = pack4_fp8(s[0 * 33] * F8_WS, s[1 * 33] * F8_WS, s[2 * 33] * F8_WS, s[3 * 33] * F8_WS); o.y = pack4_fp8(s[4 * 33] * F8_WS, s[5 * 33] * F8_WS, s[6 * 33] * F8_WS, s[7 * 33] * F8_WS);
            *(v2u*)((unsigned char*)WTv + (size_t)row * K + k0 + 8 * c) = o; }
        else { v4u o; o.x = pk2(s[0 * 33], s[1 * 33]); o.y = pk2(s[2 * 33], s[3 * 33]); o.z = pk2(s[4 * 33], s[5 * 33]); o.w = pk2(s[6 * 33], s[7 * 33]);
            *(v4u*)((bf16*)WTv + (size_t)row * K + k0 + 8 * c) = o; } }
    asm volatile("s_waitcnt lgkmcnt(0)" ::: "memory");
}

__device__ __forceinline__ void tr8_item(Frame& F, const float* W, int K, int N, unsigned char* WT, int item, int mode, float scale, int tid, int lane) {
    const int nblk = N >> 9, kb = item / nblk, nb = item - kb * nblk, k0 = 64 * kb, n0 = 512 * nb;
    LAS unsigned char* T = F.lds;
    float v[8][8];
#pragma unroll
    for (int r = 0; r < 8; ++r) { const float* src = W + (size_t)(k0 + 8 * F.wave + r) * N + n0 + lane;
#pragma unroll
        for (int i = 0; i < 8; ++i) v[r][i] = src[64 * i]; }
#pragma unroll
    for (int r = 0; r < 8; ++r)
#pragma unroll
        for (int i = 0; i < 8; i += 2) { const int pk = __builtin_amdgcn_cvt_pk_fp8_f32(clamp448(v[r][i] * scale), clamp448(v[r][i + 1] * scale), 0, false);
            T[(lane + 64 * i) * 68 + 8 * F.wave + r] = (unsigned char)(pk & 0xff); T[(lane + 64 * (i + 1)) * 68 + 8 * F.wave + r] = (unsigned char)((pk >> 8) & 0xff); }
    __syncthreads();
    { unsigned wv[16];
#pragma unroll
      for (int q = 0; q < 16; ++q) wv[q] = *(const LAS unsigned*)(T + tid * 68 + 4 * q);
      const int nn = n0 + tid; int row = nn;
      if (mode & 1) { const int oo = nn >> 1, bj = nn & 1; row = (oo >> 7) * 256 + bj * 128 + (oo & 127); }
      v4u* dst = (v4u*)(WT + (size_t)row * K + k0);
#pragma unroll
      for (int q = 0; q < 4; ++q) dst[q] = (v4u){wv[4 * q], wv[4 * q + 1], wv[4 * q + 2], wv[4 * q + 3]}; }
    __syncthreads();
}

__device__ __forceinline__ void phase_setup(Frame& F) {
    TIDLANE
    {
        const float* c = F.in[I_C]; const float* cc = F.in[I_CCTX]; const float* aw = F.in[I_ADAW]; const float* ab = F.in[I_ADAB];
        LAS float* scs = (LAS float*)F.lds;
        LAS float* red = scs + 5 * D;
        for (int i = tid; i < 5 * D; i += NTHREADS) { const int bi = i >> 10, k = i & (D - 1); const float cv = bi < 4 ? c[bi * D + k] : cc[k]; scs[i] = cv / (1.f + __expf(-cv)); }
        __syncthreads();
        for (int t = blockIdx.x; t < 4 * 96; t += F.G) {
            const int l = t / 96, jb = t % 96; float acc[5] = {0.f, 0.f, 0.f, 0.f, 0.f};
            const float* wp = aw + (size_t)l * D * 6144 + jb * 64 + lane; const int k0 = F.wave * 128;
#pragma unroll 1
            for (int kk = 0; kk < 128; kk += 16) { float wv[16];
#pragma unroll
                for (int u = 0; u < 16; ++u) wv[u] = wp[(size_t)(k0 + kk + u) * 6144];
#pragma unroll
                for (int u4 = 0; u4 < 4; ++u4)
#pragma unroll
                    for (int bi = 0; bi < 5; ++bi) { const f32x4 sv = *(const LAS f32x4*)(scs + bi * D + k0 + kk + 4 * u4);
                        acc[bi] += (sv[0] * wv[4 * u4] + sv[1] * wv[4 * u4 + 1]) + (sv[2] * wv[4 * u4 + 2] + sv[3] * wv[4 * u4 + 3]); } }
#pragma unroll
            for (int bi = 0; bi < 5; ++bi) red[(F.wave * 5 + bi) * 64 + lane] = acc[bi];
            __syncthreads();
            if (tid < 320) { const int bi = tid >> 6, j = tid & 63; float s = ab[l * 6144 + jb * 64 + j];
#pragma unroll
                for (int w = 0; w < 8; ++w) s += red[(w * 5 + bi) * 64 + j];
                F.mod[(size_t)(l * 5 + bi) * 6144 + jb * 64 + j] = s; }
            __syncthreads();
        }
    }
    { const float* rw = F.in[I_RW]; float* rwt = (float*)(F.ws + WS_RWT);
      for (int i = blockIdx.x * NTHREADS + tid; i < 4 * NEXP * D; i += F.G * NTHREADS) { const int l = i >> 15, e = (i >> 10) & 31, k = i & 1023; rwt[i] = rw[((size_t)l * D + k) * NEXP + e]; } }
    { const float* mw = F.in[I_MWIN]; float* gwt = (float*)(F.ws + WS_GWT);
      for (int i = blockIdx.x * NTHREADS + tid; i < 16 * D; i += F.G * NTHREADS) { const int g = i >> 10, k = i & 1023; gwt[i] = mw[(size_t)k * 3088 + 3072 + g]; } }
    {
        LAS float* scr = (LAS float*)(F.lds + F.wave * 16384);
        constexpr int I0 = 2 * 16 * 48, I1 = 2 * 16 * 32, I2 = 16 * 96, I3 = 16 * 32, I4 = 16 * 96, I5 = 16 * 32, I6 = 128 * 16 * 64, I7 = 128 * 16 * 32;
        constexpr int NITEMS = I0 + I1 + I2 + I3 + I4 + I5;
        for (int it = F.gw; it < NITEMS; it += F.NGW) {
            int r = it;
            if (r < I0) { const int j = r / (16 * 48); transpose_item<0, QKV_F8_A != 0>(F.in[I_AWQKV] + (size_t)j * D * 1536, D, 1536, 0, 48, F.ws + WS_AWQKV + (size_t)j * 1536 * D * (QKV_F8_A ? 1 : 2), scr, r % (16 * 48), lane, F8_DS); continue; } r -= I0;
            if (r < I1) { const int j = r / (16 * 32); transpose_item<0, WO_F8 != 0>(F.in[I_AWO] + (size_t)j * D * D, D, D, 0, 32, F.ws + WS_AWO + (size_t)j * D * D * (WO_F8 ? 1 : 2), scr, r % (16 * 32), lane, F8_DS); continue; } r -= I1;
            if (r < I2) { transpose_item<0, QKV_F8_M != 0>(F.in[I_MWIN], D, 3088, 0, 96, F.ws + WS_MWIN, scr, r, lane, F8_DS); continue; } r -= I2;
            if (r < I3) { transpose_item<0, WO_F8 != 0>(F.in[I_MWO], D, D, 0, 32, F.ws + WS_MWO, scr, r, lane, F8_DS); continue; } r -= I3;
            if (r < I4) { transpose_item<0, QKV_F8_N != 0>(F.in[I_NWQKV], D, 3072, 0, 96, F.ws + WS_NWQKV, scr, r, lane, F8_DS); continue; } r -= I4;
            if (r < I5) { transpose_item<0, WO_F8 != 0>(F.in[I_NWO], D, D, 0, 32, F.ws + WS_NWO, scr, r, lane, F8_DS); continue; } r -= I5;
            if (r < I6) { const int j = r / (16 * 64); transpose_item<1, true>(F.in[I_EWIN] + (size_t)j * D * 2048, D, 2048, 0, 64, (unsigned char*)(F.ws + WS_EWIN) + (size_t)j * 2048 * D, scr, r % (16 * 64), lane, F8_W1S); continue; } r -= I6;
            { const int j = r / (16 * 32); transpose_item<0, true>(F.in[I_EWOUT] + (size_t)j * DFF * D, DFF, D, 0, 32, (unsigned char*)(F.ws + WS_EWOUT) + (size_t)j * D * DFF, scr, r % (16 * 32), lane, F8_W2S); }
        }
    }
    __syncthreads();
    {
        constexpr int W1 = 128 * 64, W2 = 128 * 32;
        for (int it = blockIdx.x; it < W1 + W2; it += F.G) {
            if (it < W1) { const int j = it >> 6; tr8_item(F, F.in[I_EWIN] + (size_t)j * D * 2048, D, 2048, (unsigned char*)(F.ws + WS_EWIN) + (size_t)j * 2048 * D, it & 63, 1, F8_W1S, tid, lane); }
            else { const int r = it - W1, j = r >> 5; tr8_item(F, F.in[I_EWOUT] + (size_t)j * DFF * D, DFF, D, (unsigned char*)(F.ws + WS_EWOUT) + (size_t)j * D * DFF, r & 31, 0, F8_W2S, tid, lane); }
        }
    }
}

template <bool FIRST, bool GATES>
__device__ __forceinline__ void phase_pre1(Frame& F, int l, float cs) {
    TIDLANE
    const float* n1g = F.in[I_N1G] + l * D;
    if (GATES) { const f32x4* src = (const f32x4*)(F.ws + WS_GWT); f32x4 gw_[8];
#pragma unroll
        for (int i = 0; i < 8; ++i) gw_[i] = src[tid + NTHREADS * i];
#pragma unroll
        for (int i = 0; i < 8; ++i) ((LAS f32x4*)F.lds)[tid + NTHREADS * i] = gw_[i];
        __syncthreads(); }
    const float mbgv = (GATES && lane < 16) ? F.in[I_MBG][lane] : 0.f; (void)mbgv;
    f32x4 tg[4];
#pragma unroll
    for (int j = 0; j < 4; ++j) tg[j] = ((const f32x4*)n1g)[lane + 64 * j];
    for (int m = F.gw; m < T_ALL; m += F.NGW) {
        const int bidx = m < T_LAT ? m / SEQ : 4;
        const float* sh = F.mod + (size_t)(l * 5 + bidx) * 6144; const float* sc = sh + D;
        f32x4 tsc[4], tsh[4];
#pragma unroll
        for (int j = 0; j < 4; ++j) { tsc[j] = ((const f32x4*)sc)[lane + 64 * j]; tsh[j] = ((const f32x4*)sh)[lane + 64 * j]; }
        f32x4 v[4];
        if (FIRST) { const float* src = m < T_LAT ? F.in[I_X] + (size_t)m * D : F.in[I_CTX] + (size_t)(m - T_LAT) * D;
#pragma unroll
            for (int j = 0; j < 4; ++j) v[j] = ((const f32x4*)src)[lane + 64 * j]; }
        else { const float* g5 = F.mod + (size_t)((l - 1) * 5 + bidx) * 6144 + 5 * D;
#pragma unroll
            for (int j = 0; j < 4; ++j) { v[j] = ld4bf(F.X + (size_t)m * D + 4 * (lane + 64 * j)); f32x4 y = {0.f, 0.f, 0.f, 0.f};
#pragma unroll
                for (int k = 0; k < 4; ++k) {
#if YS_F8
                    const int w = ((const int*)((const unsigned char*)F.YS + (size_t)(m * 4 + k) * D))[lane + 64 * j];
                    y[0] += __builtin_amdgcn_cvt_f32_fp8(w, 0) * (1.f / F8_YS); y[1] += __builtin_amdgcn_cvt_f32_fp8(w, 1) * (1.f / F8_YS); y[2] += __builtin_amdgcn_cvt_f32_fp8(w, 2) * (1.f / F8_YS); y[3] += __builtin_amdgcn_cvt_f32_fp8(w, 3) * (1.f / F8_YS);
#else
                    const v2u w = ((const v2u*)(F.YS + (size_t)(m * 4 + k) * D))[lane + 64 * j]; y[0] += bflo(w.x); y[1] += bfhi(w.x); y[2] += bflo(w.y); y[3] += bfhi(w.y);
#endif
                }
                v[j] = v[j] + ((const f32x4*)g5)[lane + 64 * j] * y * cs; } }
#pragma unroll
        for (int j = 0; j < 4; ++j) st4bf(F.X + (size_t)m * D + 4 * (lane + 64 * j), v[j]);
        float ss = 0.f;
#pragma unroll
        for (int j = 0; j < 4; ++j) ss += (v[j][0] * v[j][0] + v[j][1] * v[j][1]) + (v[j][2] * v[j][2] + v[j][3] * v[j][3]);
        const float r = 1.f / sqrtf(wave_sum(ss) * (1.f / D) + EPS);
        f32x4 h[4];
#pragma unroll
        for (int j = 0; j < 4; ++j) { const f32x4 g = tg[j], a = tsc[j], b = tsh[j];
            h[j] = (v[j] * r * g) * (a + 1.f) + b;
            if (l == 1 ? QKV_F8_M != 0 : l == 2 ? QKV_F8_N != 0 : QKV_F8_A != 0) ((unsigned*)(F.ws + WS_H8 + (size_t)m * D))[lane + 64 * j] = pack4_fp8(h[j][0] * F8_DS, h[j][1] * F8_DS, h[j][2] * F8_DS, h[j][3] * F8_DS);
            else { v2u w; w.x = pk2(h[j][0], h[j][1]); w.y = pk2(h[j][2], h[j][3]); ((v2u*)(F.H + (size_t)m * D))[lane + 64 * j] = w; } }
        if (GATES) {
            const LAS float* wg = (const LAS float*)F.lds; float a[16];
#pragma unroll
            for (int g = 0; g < 16; ++g) { float sacc = 0.f;
#pragma unroll
                for (int j = 0; j < 4; ++j) { const f32x4 w = ((const LAS f32x4*)(wg + g * D))[lane + 64 * j]; sacc += (h[j][0] * w[0] + h[j][1] * w[1]) + (h[j][2] * w[2] + h[j][3] * w[3]); }
                a[g] = sacc; if ((g & 3) == 3) asm volatile("" ::: "memory"); }
#pragma unroll
            for (int st = 8; st >= 1; st >>= 1) {
#pragma unroll
                for (int i = 0; i < st; ++i) { const float keep = sel_mask(a[i], a[i + st], UPMASK(st)), give = sel_mask(a[i + st], a[i], UPMASK(st)); a[i] = keep + __shfl_xor(give, st); } }
            float gsum = a[0]; gsum += __shfl_xor(gsum, 16); gsum += __shfl_xor(gsum, 32);
            if (lane < 16) F.GB[(size_t)m * 16 + lane] = gsum + mbgv;
        }
    }
}

__device__ __forceinline__ void phase_pre2_valu(Frame& F, int l, bool commit, const int nrows) {
    TIDLANE
    const float* n2g = F.in[I_N2G] + l * D; const float* rb = F.in[I_RB] + l * NEXP;
    LAS float* wt = (LAS float*)F.lds;
    { const f32x4* src = (const f32x4*)((const float*)(F.ws + WS_RWT) + (size_t)l * NEXP * D);
      for (int i = tid; i < NEXP * D / 4; i += NTHREADS) ((LAS f32x4*)wt)[i] = src[i]; }
    volatile LAS unsigned* lcnt = F.MISC + 128; volatile LAS unsigned* lbase = F.MISC + 160; volatile LAS unsigned* rec = F.MISC + 256;
    f32x4 tg[4];
#pragma unroll
    for (int j = 0; j < 4; ++j) tg[j] = ((const f32x4*)n2g)[lane + 64 * j];
    const float rbv = rb[lane & 31];
    if (tid < 32) lcnt[tid] = 0u;
    __syncthreads();
    const int rows_per = nrows / 256;
    const int nblk = 256;
    for (int blk = blockIdx.x; blk < nblk; blk += F.G) {
        f32x4 vn[4];
        { const int m0 = blk * rows_per + F.wave;
#pragma unroll
          for (int j = 0; j < 4; ++j) vn[j] = ld4bf(F.X + (size_t)m0 * D + 4 * (lane + 64 * j)); }
        for (int ri = F.wave; ri < rows_per; ri += NWAVES) {
            const int m = blk * rows_per + ri; const int bidx = m < T_LAT ? m / SEQ : 4;
            f32x4 v[4]; float ss = 0.f;
#pragma unroll
            for (int j = 0; j < 4; ++j) { v[j] = vn[j]; ss += (v[j][0] * v[j][0] + v[j][1] * v[j][1]) + (v[j][2] * v[j][2] + v[j][3] * v[j][3]); }
            if (ri + NWAVES < rows_per) {
#pragma unroll
                for (int j = 0; j < 4; ++j) vn[j] = ld4bf(F.X + (size_t)(m + NWAVES) * D + 4 * (lane + 64 * j)); }
            const float r = 1.f / sqrtf(wave_sum(ss) * (1.f / D) + EPS);
            const float* sh = F.mod + (size_t)(l * 5 + bidx) * 6144 + 3 * D; const float* sc = sh + D;
            f32x4 h[4];
#pragma unroll
            for (int j = 0; j < 4; ++j) { const f32x4 g = ((const f32x4*)n2g)[lane + 64 * j], a = ((const f32x4*)sc)[lane + 64 * j], b = ((const f32x4*)sh)[lane + 64 * j];
                h[j] = (v[j] * r * g) * (a + 1.f) + b;
                ((unsigned*)(F.ws + WS_H8 + (size_t)m * D))[lane + 64 * j] = pack4_fp8(h[j][0] * F8_HS, h[j][1] * F8_HS, h[j][2] * F8_HS, h[j][3] * F8_HS); }
            float a[32];
#define P2_RD(dst, e) do { _Pragma("unroll") for (int j_ = 0; j_ < 4; ++j_) dst[j_] = ((const LAS f32x4*)(wt + (e) * D))[lane + 64 * j_]; } while (0)
#define P2_DOT(dst, w) do { float s_ = 0.f; _Pragma("unroll") for (int j_ = 0; j_ < 4; ++j_) { s_ = __builtin_fmaf(h[j_][0], w[j_][0], s_); s_ = __builtin_fmaf(h[j_][1], w[j_][1], s_); s_ = __builtin_fmaf(h[j_][2], w[j_][2], s_); s_ = __builtin_fmaf(h[j_][3], w[j_][3], s_); } dst = s_; } while (0)
            { f32x4 wa0[4], wa1[4], wb0[4], wb1[4];
              P2_RD(wa0, 0); P2_RD(wa1, 1);
#pragma unroll
              for (int e0 = 0; e0 < 32; e0 += 4) {
                  P2_RD(wb0, e0 + 2); P2_RD(wb1, e0 + 3);
                  __builtin_amdgcn_sched_barrier(0);
                  P2_DOT(a[e0], wa0); P2_DOT(a[e0 + 1], wa1);
                  __builtin_amdgcn_sched_barrier(0);
                  if (e0 + 4 < 32) { P2_RD(wa0, e0 + 4); P2_RD(wa1, e0 + 5); }
                  __builtin_amdgcn_sched_barrier(0);
                  P2_DOT(a[e0 + 2], wb0); P2_DOT(a[e0 + 3], wb1);
                  __builtin_amdgcn_sched_barrier(0);
              } }
#undef P2_RD
#undef P2_DOT
#pragma unroll
            for (int st = 16; st >= 1; st >>= 1) {
#pragma unroll
                for (int i = 0; i < st; ++i) { const float keep = sel_mask(a[i], a[i + st], UPMASK(st)), give = sel_mask(a[i + st], a[i], UPMASK(st)); a[i] = keep + __shfl_xor(give, st); } }
            float logit = a[0]; logit += __shfl_xor(logit, 32); logit += rb[lane & 31];
            int rank = 0; const int me = lane & 31;
#pragma unroll
            for (int k = 1; k < 32; ++k) { const int src = (lane & 32) | ((lane + k) & 31); const float ov = __shfl(logit, src); const int oe = (me + k) & 31; rank += (ov > logit || (ov == logit && oe < me)) ? 1 : 0; }
            unsigned long long bm = __ballot(rank < 4 && lane < 32);
            const int e0 = __ffsll((long long)bm) - 1; bm &= bm - 1; const int e1 = __ffsll((long long)bm) - 1; bm &= bm - 1; const int e2 = __ffsll((long long)bm) - 1; bm &= bm - 1; const int e3 = __ffsll((long long)bm) - 1;
            const float t0 = __shfl(logit, e0), t1 = __shfl(logit, e1), t2 = __shfl(logit, e2), t3 = __shfl(logit, e3);
            const float tm = fmaxf(fmaxf(t0, t1), fmaxf(t2, t3));
            const float x0 = __expf(t0 - tm), x1 = __expf(t1 - tm), x2 = __expf(t2 - tm), x3 = __expf(t3 - tm); const float inv = 1.f / ((x0 + x1) + (x2 + x3));
            if (lane < 4) { const int k = lane; const int e = k == 0 ? e0 : k == 1 ? e1 : k == 2 ? e2 : e3; const float g = (k == 0 ? x0 : k == 1 ? x1 : k == 2 ? x2 : x3) * inv;
                const unsigned lp = __hip_atomic_fetch_add((LAS unsigned*)&lcnt[e], 1u, __ATOMIC_RELAXED, __HIP_MEMORY_SCOPE_WORKGROUP);
                const int ridx = (ri * 4 + k) * 3; rec[ridx] = (unsigned)e | (lp << 8); rec[ridx + 1] = (unsigned)(m * 4 + k); rec[ridx + 2] = __float_as_uint(g); }
        }
        __syncthreads();
        if (tid < 32) { const unsigned n = lcnt[tid]; lbase[tid] = (n && commit) ? xb_add(F.ctl + CW_CNT + (l * 32 + tid) * 64, n) : 0u; }
        __syncthreads();
        if (commit) for (int i = tid; i < rows_per * 4; i += NTHREADS) { const unsigned w0 = rec[i * 3]; const int e = w0 & 255; const unsigned pos = lbase[e] + (w0 >> 8);
            F.slot_of[(size_t)e * T_ALL + pos] = (int)rec[i * 3 + 1]; F.gate_of[(size_t)e * T_ALL + pos] = __uint_as_float(rec[i * 3 + 2]); }
        __syncthreads();
        if (tid < 32) lcnt[tid] = 0u;
        __syncthreads();
    }
}

__device__ __forceinline__ void split_pk(float x0, float x1, unsigned& hi, unsigned& lo) { hi = cvt_pk_bf16(x0, x1); lo = cvt_pk_bf16(x0 - bflo(hi), x1 - bfhi(hi)); }
__device__ __forceinline__ void phase_pre2(Frame& F, int l, bool commit, const int nrows) {
    TIDLANE
    const int w = F.wave, fr = lane & 15, kq = lane >> 4;
    const float* n2g = F.in[I_N2G] + l * D; const float* rb = F.in[I_RB] + l * NEXP;
    constexpr int APITCH = 2064;
    LAS unsigned char* AH = F.lds; LAS unsigned char* AL = F.lds + 16 * APITCH; LAS float* RED = (LAS float*)(F.lds + 32 * APITCH);
    volatile LAS unsigned* lcnt = F.MISC + 128; volatile LAS unsigned* lbase = F.MISC + 160; volatile LAS unsigned* rec = F.MISC + 256;
    bf16x8 Bh[4][2], Bl[4][2];
    { const float* rwt = (const float*)(F.ws + WS_RWT) + (size_t)l * NEXP * D; f32x4 rwa[4][2], rwb[4][2];
#pragma unroll
      for (int ks = 0; ks < 4; ++ks)
#pragma unroll
          for (int nb = 0; nb < 2; ++nb) { const f32x4* p = (const f32x4*)(rwt + (size_t)(fr + 16 * nb) * D + 128 * w + 32 * ks + 8 * kq); rwa[ks][nb] = p[0]; rwb[ks][nb] = p[1]; }
      __builtin_amdgcn_sched_barrier(0);
#pragma unroll
      for (int ks = 0; ks < 4; ++ks)
#pragma unroll
          for (int nb = 0; nb < 2; ++nb) { const f32x4 a = rwa[ks][nb], b = rwb[ks][nb];
              unsigned h0, h1, h2, h3, l0, l1, l2, l3; split_pk(a[0], a[1], h0, l0); split_pk(a[2], a[3], h1, l1); split_pk(b[0], b[1], h2, l2); split_pk(b[2], b[3], h3, l3);
              const v4u hi = {h0, h1, h2, h3}, lo = {l0, l1, l2, l3};
              Bh[ks][nb] = __builtin_bit_cast(bf16x8, hi); Bl[ks][nb] = __builtin_bit_cast(bf16x8, lo); } }
    f32x4 tg[4];
#pragma unroll
    for (int j = 0; j < 4; ++j) tg[j] = ((const f32x4*)n2g)[lane + 64 * j];
    const float rbv = rb[lane & 31];
    if (tid < 32) lcnt[tid] = 0u;
    __syncthreads();
    const int rows_per = nrows / 256;
    const int nb16 = (rows_per + 15) >> 4;
    for (int blk = blockIdx.x; blk < 256; blk += F.G) {
        v2u xn[2][4];
#pragma unroll
        for (int i = 0; i < 2; ++i) { const int rc = (2 * w + i) < rows_per ? (2 * w + i) : rows_per - 1; const bf16* xp = F.X + (size_t)(blk * rows_per + rc) * D;
#pragma unroll
            for (int j = 0; j < 4; ++j) xn[i][j] = *(const v2u*)(xp + 4 * (lane + 64 * j)); }
        for (int b16 = 0; b16 < nb16; ++b16) {
            f32x4 tsc2[2][4], tsh2[2][4];
#pragma unroll
            for (int i = 0; i < 2; ++i) { const int ri_ = 16 * b16 + 2 * w + i; const int m_ = blk * rows_per + (ri_ < rows_per ? ri_ : rows_per - 1); const int bi_ = m_ < T_LAT ? m_ / SEQ : 4;
                const float* sh_ = F.mod + (size_t)(l * 5 + bi_) * 6144 + 3 * D;
#pragma unroll
                for (int j = 0; j < 4; ++j) { tsc2[i][j] = ((const f32x4*)(sh_ + D))[lane + 64 * j]; tsh2[i][j] = ((const f32x4*)sh_)[lane + 64 * j]; } }
            __builtin_amdgcn_sched_barrier(0);
#pragma unroll
            for (int i = 0; i < 2; ++i) {
                const int ri = 16 * b16 + 2 * w + i; const bool valid = ri < rows_per; const int m = blk * rows_per + (valid ? ri : rows_per - 1);
                f32x4 v[4]; float ss = 0.f;
                const f32x4 (&tsc)[4] = tsc2[i]; const f32x4 (&tsh)[4] = tsh2[i];
#pragma unroll
                for (int j = 0; j < 4; ++j) { const v2u xw = xn[i][j]; v[j] = (f32x4){bflo(xw.x), bfhi(xw.x), bflo(xw.y), bfhi(xw.y)}; ss += (v[j][0] * v[j][0] + v[j][1] * v[j][1]) + (v[j][2] * v[j][2] + v[j][3] * v[j][3]); }
                if (b16 + 1 < nb16) { const int r2 = ri + 16; const bf16* xp = F.X + (size_t)(blk * rows_per + (r2 < rows_per ? r2 : rows_per - 1)) * D;
#pragma unroll
                    for (int j = 0; j < 4; ++j) xn[i][j] = *(const v2u*)(xp + 4 * (lane + 64 * j)); }
                const float r = 1.f / sqrtf(wave_sum(ss) * (1.f / D) + EPS);
#pragma unroll
                for (int j = 0; j < 4; ++j) { const f32x4 g = tg[j], a = tsc[j], b = tsh[j];
                    const f32x4 h = (v[j] * r * g) * (a + 1.f) + b;
                    ((unsigned*)(F.ws + WS_H8 + (size_t)m * D))[lane + 64 * j] = pack4_fp8(h[0] * F8_HS, h[1] * F8_HS, h[2] * F8_HS, h[3] * F8_HS);
                    unsigned h0, h1, l0, l1; split_pk(h[0], h[1], h0, l0); split_pk(h[2], h[3], h1, l1); const v2u hi = {h0, h1}, lo = {l0, l1};
                    *(LAS v2u*)(AH + (2 * w + i) * APITCH + (4 * lane + 256 * j) * 2) = hi; *(LAS v2u*)(AL + (2 * w + i) * APITCH + (4 * lane + 256 * j) * 2) = lo; }
            }
            __syncthreads();
            { f32x4 acc[2] = {{0.f, 0.f, 0.f, 0.f}, {0.f, 0.f, 0.f, 0.f}}; bf16x8 ah[4], al[4];
#pragma unroll
              for (int ks = 0; ks < 4; ++ks) { ah[ks] = *(const LAS bf16x8*)(AH + fr * APITCH + (128 * w + 32 * ks + 8 * kq) * 2); al[ks] = *(const LAS bf16x8*)(AL + fr * APITCH + (128 * w + 32 * ks + 8 * kq) * 2); }
#pragma unroll
              for (int ks = 0; ks < 4; ++ks)
#pragma unroll
                  for (int nb = 0; nb < 2; ++nb) { acc[nb] = __builtin_amdgcn_mfma_f32_16x16x32_bf16(ah[ks], Bh[ks][nb], acc[nb], 0, 0, 0);
                      acc[nb] = __builtin_amdgcn_mfma_f32_16x16x32_bf16(ah[ks], Bl[ks][nb], acc[nb], 0, 0, 0); acc[nb] = __builtin_amdgcn_mfma_f32_16x16x32_bf16(al[ks], Bh[ks][nb], acc[nb], 0, 0, 0); }
#pragma unroll
              for (int nb = 0; nb < 2; ++nb)
#pragma unroll
                  for (int i = 0; i < 4; ++i) RED[(w * 16 + kq * 4 + i) * 32 + 16 * nb + fr] = acc[nb][i]; }
            __syncthreads();
            { const int row16 = 2 * w + (lane >> 5), me = lane & 31, ri = 16 * b16 + row16; const bool valid = ri < rows_per; const int m = blk * rows_per + ri;
              float logit = rbv;
#pragma unroll
              for (int ww = 0; ww < 8; ++ww) logit += RED[(ww * 16 + row16) * 32 + me];
              float lg = logit; const bool up = lane >= 32; int e0, e1, e2, e3; float t0, t1, t2, t3;
#define P2_ROUND(EK, TK) do { const float NI_ = -3.0e38f; float s_ = lg; \
                  s_ = fmaxf(s_, dpp_f(NI_, s_, 0x111, 0xf)); s_ = fmaxf(s_, dpp_f(NI_, s_, 0x112, 0xf)); s_ = fmaxf(s_, dpp_f(NI_, s_, 0x114, 0xf)); s_ = fmaxf(s_, dpp_f(NI_, s_, 0x118, 0xf)); \
                  s_ = fmaxf(s_, dpp_f(NI_, s_, 0x142, 0xa)); \
                  const float mA_ = __builtin_bit_cast(float, __builtin_amdgcn_readlane(__builtin_bit_cast(int, s_), 31)), mB_ = __builtin_bit_cast(float, __builtin_amdgcn_readlane(__builtin_bit_cast(int, s_), 63)); \
                  TK = up ? mB_ : mA_; const unsigned long long bal_ = __ballot(lg == TK); \
                  const int ea_ = __ffs((unsigned)bal_) - 1, eb_ = __ffs((unsigned)(bal_ >> 32)) - 1; EK = up ? eb_ : ea_; if (me == EK) lg = NI_; } while (0)
              P2_ROUND(e0, t0); P2_ROUND(e1, t1); P2_ROUND(e2, t2); P2_ROUND(e3, t3);
#undef P2_ROUND
              const float x0 = 1.f, x1 = __expf(t1 - t0), x2 = __expf(t2 - t0), x3 = __expf(t3 - t0); const float inv = 1.f / ((x0 + x1) + (x2 + x3));
              if (me < 4 && valid) { const int k = me; const int e = k == 0 ? e0 : k == 1 ? e1 : k == 2 ? e2 : e3; const float g = (k == 0 ? x0 : k == 1 ? x1 : k == 2 ? x2 : x3) * inv;
                  const unsigned lp = __hip_atomic_fetch_add((LAS unsigned*)&lcnt[e], 1u, __ATOMIC_RELAXED, __HIP_MEMORY_SCOPE_WORKGROUP);
                  const int ridx = (ri * 4 + k) * 3; rec[ridx] = (unsigned)e | (lp << 8); rec[ridx + 1] = (unsigned)(m * 4 + k); rec[ridx + 2] = __float_as_uint(g); } }
        }
        __syncthreads();
        if (tid < 32) { const unsigned n = lcnt[tid]; lbase[tid] = (n && commit) ? xb_add(F.ctl + CW_CNT + (l * 32 + tid) * 64, n) : 0u; }
        __syncthreads();
        if (commit) for (int i = tid; i < rows_per * 4; i += NTHREADS) { const unsigned w0 = rec[i * 3]; const int e = w0 & 255; const unsigned pos = lbase[e] + (w0 >> 8);
            F.slot_of[(size_t)e * T_ALL + pos] = (int)rec[i * 3 + 1]; F.gate_of[(size_t)e * T_ALL + pos] = __uint_as_float(rec[i * 3 + 2]); }
        __syncthreads();
        if (tid < 32) lcnt[tid] = 0u;
        __syncthreads();
    }
}

__device__ __forceinline__ void moe_tables(Frame& F, int l) {
    TIDLANE
    __syncthreads();
    if (F.wave == 0) {
        const int c = lane < NEXP ? (int)xb_ld(F.ctl + CW_CNT + (l * 32 + lane) * 64) : 0; const int t = (c + 255) >> 8;
        int incl = t;
#pragma unroll
        for (int o = 1; o < 32; o <<= 1) { const int v = __shfl_up(incl, o); if (lane >= o) incl += v; }
        if (lane < NEXP) { F.MISC[64 + lane] = (unsigned)c; F.MISC[16 + lane] = (unsigned)(incl - t); }
        if (lane == NEXP - 1) F.MISC[16 + NEXP] = (unsigned)incl;
    }
    __syncthreads();
}

template <int MODE>
__device__ __forceinline__ void phase_attn_naive(Frame& F, const float* sink, const float* rpb) {
    TIDLANE
    constexpr int LD = MODE == 0 ? 1536 : 3072;
    for (int task = F.gw; task < T_ALL * 16; task += F.NGW) {
        const int m = task >> 4, h = task & 15; const bool isctx = m >= T_LAT;
        const int b = isctx ? (m - T_LAT) / LC : m / SEQ, s = m & (SEQ - 1);
        const int kcol = MODE == 0 ? 1024 + (h >> 2) * 64 : 1024 + h * 64, vcol = MODE == 0 ? 1280 + (h >> 2) * 64 : 2048 + h * 64;
        float q[64];
        { const v4u* qp = (const v4u*)(F.QKV + (size_t)m * LD + h * 64);
#pragma unroll
          for (int i = 0; i < 8; ++i) { const v4u w = qp[i]; q[8 * i] = bflo(w.x) * 0.125f; q[8 * i + 1] = bfhi(w.x) * 0.125f; q[8 * i + 2] = bflo(w.y) * 0.125f; q[8 * i + 3] = bfhi(w.y) * 0.125f;
              q[8 * i + 4] = bflo(w.z) * 0.125f; q[8 * i + 5] = bfhi(w.z) * 0.125f; q[8 * i + 6] = bflo(w.w) * 0.125f; q[8 * i + 7] = bfhi(w.w) * 0.125f; } }
        constexpr int NP = MODE == 0 ? 9 : 6;
        float sc[NP]; int krow[NP];
        const int r = s >> 6, qc = s & 63; int rs = r - 4; rs = rs < 0 ? 0 : (rs > 120 ? 120 : rs); int cst = qc - 8; cst = cst < 0 ? 0 : (cst > 48 ? 48 : cst);
#pragma unroll
        for (int p = 0; p < NP; ++p) {
            bool valid = true; int kr; float bias = 0.f;
            if (p < 4) kr = T_LAT + b * LC + 64 * p + lane;
            else if (MODE == 0) { const int kp = s - 128 + 64 * (p - 4) + lane; valid = !isctx && kp >= 0 && kp < SEQ && kp <= s + 128; kr = b * SEQ + (valid ? kp : 0); }
            else { const int j = 64 * (p - 4) + lane; const int kro = j >> 4, kc = cst + (j & 15); valid = !isctx; kr = b * SEQ + (rs + kro) * 64 + kc;
                   bias = rpb[h * 465 + (rs + kro - r + 7) * 31 + (kc - qc + 15)]; }
            krow[p] = kr; float d = 0.f;
            if (valid) { const v4u* kp_ = (const v4u*)(F.QKV + (size_t)kr * LD + kcol);
#pragma unroll
                for (int i = 0; i < 8; ++i) { const v4u w = kp_[i]; d += q[8 * i] * bflo(w.x) + q[8 * i + 1] * bfhi(w.x) + q[8 * i + 2] * bflo(w.y) + q[8 * i + 3] * bfhi(w.y)
                    + q[8 * i + 4] * bflo(w.z) + q[8 * i + 5] * bfhi(w.z) + q[8 * i + 6] * bflo(w.w) + q[8 * i + 7] * bfhi(w.w); } }
            sc[p] = valid ? d + bias : -INFINITY;
        }
        float mx = MODE == 0 ? sink[h] : -INFINITY;
#pragma unroll
        for (int p = 0; p < NP; ++p) mx = fmaxf(mx, sc[p]);
        mx = wave_max(mx);
        float den = 0.f;
#pragma unroll
        for (int p = 0; p < NP; ++p) { sc[p] = __expf(sc[p] - mx); den += sc[p]; }
        den = wave_sum(den); if (MODE == 0) den += __expf(sink[h] - mx);
        float o = 0.f;
#pragma unroll
        for (int p = 0; p < NP; ++p) { if (p >= 4 && isctx) continue;
            for (int j = 0; j < 64; ++j) { const float pj = __shfl(sc[p], j); const int kr = __shfl(krow[p], j);
                if (pj != 0.f) o += pj * bf2f(F.QKV[(size_t)kr * LD + vcol + lane]); } }
        F.O[(size_t)m * D + h * 64 + lane] = (bf16)f2bf(o / den);
    }
}


typedef float f32x16 __attribute__((ext_vector_type(16)));
typedef short s16x4 __attribute__((ext_vector_type(4)));
typedef short v4i16_t __attribute__((ext_vector_type(4)));
__device__ __forceinline__ s16x4 ds_tr(const LAS unsigned char* p) { return __builtin_bit_cast(s16x4, __builtin_amdgcn_ds_read_tr16_b64_v4i16((LAS v4i16_t*)p)); }
__device__ __forceinline__ int crow(int r, int hi) { return (r & 3) + 8 * (r >> 2) + 4 * hi; }
constexpr int AT_KB = 9216, AT_VB = 8320, AT_VD = 4160;
constexpr float LOG2E = 1.4426950408889634f;

template <int MODE>
__device__ __forceinline__ void phase_attn(Frame& F, const float* sink, const float* rpb, const bool with_ctx) {
    TIDLANE
    constexpr int LD = MODE == 0 ? 1536 : 3072;
    constexpr float NEG = -1e30f;
    const int w = F.wave, r32 = lane & 31, hi = lane >> 5, g16 = lane >> 4, i16 = lane & 15;
    LAS unsigned char* KL = F.lds; LAS unsigned char* VL = F.lds + 2 * AT_KB; LAS float* RPB = (LAS float*)(F.lds + 2 * AT_KB + 2 * AT_VB);
    const int skey = tid >> 3, sch = tid & 7;
    const unsigned kw_off = skey * 144 + sch * 16, vw_off = (sch >> 2) * AT_VD + skey * 64 + (sch & 3) * 16;
    const unsigned vr_off = (4 * (g16 >> 1) + (i16 >> 2)) * 64 + (16 * (g16 & 1) + 4 * (i16 & 3)) * 2;
    const unsigned kr_off = r32 * 144 + hi * 16;
    constexpr int NLAT = 2048; const int NUNITS = with_ctx ? NLAT + 64 : NLAT;
    for (int it = 0;; ++it) {
        const int L = it * F.G + F.vcu; if (L >= NUNITS) break;
        const bool isctx = L >= NLAT;
        int b, head, qrow, kcol, vcol, ntiles, q0 = 0, ltmin = 0, rs_lo = 0, rw = 0, rsw = 0;
        if (MODE == 0) {
            int kvh, qb;
            if (!isctx) { b = L >> 9; kvh = (L >> 7) & 3; qb = L & 127; q0 = qb * 64; qrow = b * SEQ + q0 + 32 * (w & 1) + r32;
                ltmin = qb < 2 ? -qb : -2; const int ltmax = (127 - qb) < 2 ? (127 - qb) : 2; ntiles = 4 + (ltmax - ltmin + 1); }
            else { const int L2 = L - NLAT; b = L2 >> 4; kvh = (L2 >> 2) & 3; qb = L2 & 3; qrow = T_LAT + b * LC + qb * 64 + 32 * (w & 1) + r32; ntiles = 4; }
            head = kvh * 4 + (w >> 1); kcol = 1024 + kvh * 64; vcol = 1280 + kvh * 64;
        } else {
            if (!isctx) { b = L >> 9; head = (L >> 5) & 15; const int rg = L & 31; const int r0 = rg * 4; qrow = b * SEQ + r0 * 64 + 32 * w + r32;
                rs_lo = r0 - 4; rs_lo = rs_lo < 0 ? 0 : (rs_lo > 120 ? 120 : rs_lo); int rs_hi = r0 - 1; rs_hi = rs_hi < 0 ? 0 : (rs_hi > 120 ? 120 : rs_hi);
                ntiles = 4 + (rs_hi + 8 - rs_lo); rw = r0 + (w >> 1); rsw = rw - 4; rsw = rsw < 0 ? 0 : (rsw > 120 ? 120 : rsw); }
            else { const int L2 = L - NLAT; b = L2 >> 4; head = L2 & 15; qrow = T_LAT + b * LC + 32 * w + r32; ntiles = 4; }
            kcol = 1024 + head * 64; vcol = 2048 + head * 64;
        }
        bf16x8 qf[4];
#pragma unroll
        for (int ks = 0; ks < 4; ++ks) qf[ks] = *(const bf16x8*)(F.QKV + (size_t)qrow * LD + head * 64 + 16 * ks + 8 * hi);
        float mrun = MODE == 0 ? sink[head] * 8.f : NEG, lrun = MODE == 0 ? 1.f : 0.f;
        f32x16 o0, o1, o2;
#pragma unroll
        for (int r = 0; r < 16; ++r) { o0[r] = 0.f; o1[r] = 0.f; o2[r] = 0.f; }
        const int qc = (MODE == 0 ? 32 * (w & 1) : 32 * (w & 1)) + r32;
        int cst = qc - 8; cst = cst < 0 ? 0 : (cst > 48 ? 48 : cst);
#define AT_ROWBASE(t) ((t) < 4 ? T_LAT + b * LC + 64 * (t) : (MODE == 0 ? b * SEQ + q0 + 64 * (ltmin + (t) - 4) : b * SEQ + (rs_lo + (t) - 4) * 64))
        v4u kr0, vr0, kr1 = {0u, 0u, 0u, 0u}, vr1 = {0u, 0u, 0u, 0u};
        { const bf16* rp = F.QKV + (size_t)(AT_ROWBASE(0) + skey) * LD + sch * 8; kr0 = *(const v4u*)(rp + kcol); vr0 = *(const v4u*)(rp + vcol); }
        float rpbv = 0.f; if (MODE == 1 && tid < 465) rpbv = rpb[head * 465 + tid] * 8.f;
        __syncthreads();
        if (MODE == 1 && tid < 465) RPB[tid] = rpbv;
        *(LAS v4u*)(KL + kw_off) = kr0; *(LAS v4u*)(VL + vw_off) = vr0;
        { const bf16* rp = F.QKV + (size_t)(AT_ROWBASE(1) + skey) * LD + sch * 8; kr0 = *(const v4u*)(rp + kcol); vr0 = *(const v4u*)(rp + vcol); }
        __syncthreads();
#define AT_BIAS(SV, R0_, R1_, KOFF) do { float bb_[16]; \
            _Pragma("unroll") \
                for (int r = (R0_); r < (R1_); ++r) { int d_ = crow(r, hi) + (KOFF) - qc + 15; d_ = d_ < 0 ? 0 : (d_ > 30 ? 30 : d_); bb_[r] = bp[d_]; } \
                __builtin_amdgcn_sched_barrier(0); \
            _Pragma("unroll") \
                for (int r = (R0_); r < (R1_); ++r) SV[r] = ((unsigned)(crow(r, hi) + (KOFF) - cst) < 16u) ? SV[r] + bb_[r] : NEG; } while (0)
#define AT_ITER(T_, LK, LV, WK_, WV_) do { const int t = (T_); const int buf = t & 1; \
            if (t + 2 < ntiles) { const bf16* rp = F.QKV + (size_t)(AT_ROWBASE(t + 2) + skey) * LD + sch * 8; LK = *(const v4u*)(rp + kcol); LV = *(const v4u*)(rp + vcol); } \
            bool active = true; int kr = 0; \
            if (MODE == 1 && t >= 4) { kr = rs_lo + t - 4; active = (kr >= rsw) && (kr < rsw + 8); } \
            if (active) { \
                const LAS unsigned char* Kb = KL + buf * AT_KB + kr_off; const LAS unsigned char* Vb = VL + buf * AT_VB + vr_off; \
                f32x16 s0, s1; \
            _Pragma("unroll") \
                for (int r = 0; r < 16; ++r) { s0[r] = 0.f; s1[r] = 0.f; } \
                bf16x8 kf0[4], kf1[4]; \
            _Pragma("unroll") \
                for (int ks = 0; ks < 4; ++ks) { kf0[ks] = *(const LAS bf16x8*)(Kb + ks * 32); kf1[ks] = *(const LAS bf16x8*)(Kb + 32 * 144 + ks * 32); } \
                __builtin_amdgcn_sched_barrier(0); \
            _Pragma("unroll") \
                for (int ks = 0; ks < 4; ++ks) { s0 = __builtin_amdgcn_mfma_f32_32x32x16_bf16(kf0[ks], qf[ks], s0, 0, 0, 0); s1 = __builtin_amdgcn_mfma_f32_32x32x16_bf16(kf1[ks], qf[ks], s1, 0, 0, 0); } \
                __builtin_amdgcn_sched_barrier(0); \
                constexpr float C2 = 0.125f * LOG2E; \
                if (MODE == 0 && t >= 4) { const int lt = ltmin + t - 4; \
                    if (lt == -2 || lt == 2) { const int d0 = 64 * lt - qc; \
            _Pragma("unroll") \
                        for (int r = 0; r < 16; ++r) { const int dd0 = d0 + crow(r, hi), dd1 = dd0 + 32; if (dd0 > 128 || dd0 < -128) s0[r] = NEG; if (dd1 > 128 || dd1 < -128) s1[r] = NEG; } } } \
                  \
                  \
                const bool nwin = (MODE == 1) && t >= 4; const bool lowc = (w & 1) == 0; \
                if (nwin) { const LAS float* bp = RPB + (kr - rw + 7) * 31; \
                    if (lowc) { AT_BIAS(s0, 0, 16, 0); AT_BIAS(s1, 0, 4, 32); } else { AT_BIAS(s0, 12, 16, 0); AT_BIAS(s1, 0, 16, 32); } } \
                float mt, mt2; \
                if (nwin && lowc) { mt = fmax3_s(s0[0], s1[0], s0[2]); mt2 = fmax3_s(s0[1], s1[1], s0[3]); mt = fmax3_s(mt, s1[2], s0[4]); mt2 = fmax3_s(mt2, s1[3], s0[5]); \
            _Pragma("unroll") \
                    for (int r = 6; r < 16; r += 2) { mt = fmaxf(mt, s0[r]); mt2 = fmaxf(mt2, s0[r + 1]); } } \
                else if (nwin) { mt = fmax3_s(s1[0], s0[12], s0[14]); mt2 = fmax3_s(s1[1], s0[13], s0[15]); \
            _Pragma("unroll") \
                    for (int r = 2; r < 16; r += 2) { mt = fmaxf(mt, s1[r]); mt2 = fmaxf(mt2, s1[r + 1]); } } \
                else { mt = fmaxf(s0[0], s1[0]); mt2 = fmaxf(s0[1], s1[1]); \
            _Pragma("unroll") \
                    for (int r = 2; r < 16; r += 2) { mt = fmax3_s(mt, s0[r], s1[r]); mt2 = fmax3_s(mt2, s0[r + 1], s1[r + 1]); } } \
                mt = fmaxf(mt, mt2); \
                mt = fmaxf(mt, __shfl_xor(mt, 32)); \
                if (__any(mt > mrun + (8.f / C2))) {        \
                    const float mn = fmaxf(mrun, mt), alpha = __builtin_amdgcn_exp2f((mrun - mn) * C2); mrun = mn; lrun *= alpha; \
            _Pragma("unroll") \
                    for (int r = 0; r < 16; ++r) { o0[r] *= alpha; o1[r] *= alpha; o2[r] *= alpha; } } \
                const float negm = -mrun * C2; \
                if (nwin && lowc) { \
            _Pragma("unroll") \
                    for (int r = 0; r < 16; ++r) { s0[r] = __builtin_amdgcn_exp2f(__builtin_fmaf(s0[r], C2, negm)); s1[r] = r < 4 ? __builtin_amdgcn_exp2f(__builtin_fmaf(s1[r], C2, negm)) : 0.f; } } \
                else if (nwin) { \
            _Pragma("unroll") \
                    for (int r = 0; r < 16; ++r) { s1[r] = __builtin_amdgcn_exp2f(__builtin_fmaf(s1[r], C2, negm)); s0[r] = r >= 12 ? __builtin_amdgcn_exp2f(__builtin_fmaf(s0[r], C2, negm)) : 0.f; } } \
                else { \
            _Pragma("unroll") \
                    for (int r = 0; r < 16; ++r) { s0[r] = __builtin_amdgcn_exp2f(__builtin_fmaf(s0[r], C2, negm)); s1[r] = __builtin_amdgcn_exp2f(__builtin_fmaf(s1[r], C2, negm)); } } \
                const int sskip = nwin ? (lowc ? 3 : 0) : -1; \
                bf16x8 pf[4]; \
            _Pragma("unroll") \
                for (int s = 0; s < 4; ++s) { const f32x16& sv = (s < 2) ? s0 : s1; const int rb = 8 * (s & 1); \
                    v4u pk; pk.x = cvt_pk_bf16(sv[rb], sv[rb + 1]); pk.y = cvt_pk_bf16(sv[rb + 2], sv[rb + 3]); pk.z = cvt_pk_bf16(sv[rb + 4], sv[rb + 5]); pk.w = cvt_pk_bf16(sv[rb + 6], sv[rb + 7]); \
                    pf[s] = __builtin_bit_cast(bf16x8, pk); } \
            _Pragma("unroll") \
                for (int s = 0; s < 4; ++s) if (s != sskip) { \
                    const s16x4 a0 = ds_tr(Vb + s * 1024), a1 = ds_tr(Vb + s * 1024 + 512), c0 = ds_tr(Vb + AT_VD + s * 1024), c1 = ds_tr(Vb + AT_VD + s * 1024 + 512); \
                    const bf16x8 v0 = (bf16x8){a0[0], a0[1], a0[2], a0[3], a1[0], a1[1], a1[2], a1[3]}, v1 = (bf16x8){c0[0], c0[1], c0[2], c0[3], c1[0], c1[1], c1[2], c1[3]}; \
                    o0 = __builtin_amdgcn_mfma_f32_32x32x16_bf16(v0, pf[s], o0, 0, 0, 0); o1 = __builtin_amdgcn_mfma_f32_32x32x16_bf16(v1, pf[s], o1, 0, 0, 0); \
                    o2 = __builtin_amdgcn_mfma_f32_32x32x16_bf16((bf16x8){0x3F80, 0x3F80, 0x3F80, 0x3F80, 0x3F80, 0x3F80, 0x3F80, 0x3F80}, pf[s], o2, 0, 0, 0); } \
            } \
            if (t + 1 < ntiles) { *(LAS v4u*)(KL + (buf ^ 1) * AT_KB + kw_off) = WK_; *(LAS v4u*)(VL + (buf ^ 1) * AT_VB + vw_off) = WV_; } \
            __syncthreads(); } while (0)
        for (int tt = 0; tt < ntiles; tt += 2) { AT_ITER(tt, kr1, vr1, kr0, vr0); if (tt + 1 < ntiles) AT_ITER(tt + 1, kr0, vr0, kr1, vr1); }
#undef AT_ITER
#undef AT_BIAS
#undef AT_ROWBASE
        const float inv = 1.f / (lrun + o2[0]);
        if (WO_F8) { unsigned char* op8 = (unsigned char*)F.O + (size_t)qrow * D + head * 64 + 16 * hi; const float sc8 = inv * F8_DS;
            unsigned da[4], db[4];
#pragma unroll
            for (int rr = 0; rr < 4; ++rr) { da[rr] = pack4_fp8(o0[4 * rr] * sc8, o0[4 * rr + 1] * sc8, o0[4 * rr + 2] * sc8, o0[4 * rr + 3] * sc8);
                db[rr] = pack4_fp8(o1[4 * rr] * sc8, o1[4 * rr + 1] * sc8, o1[4 * rr + 2] * sc8, o1[4 * rr + 3] * sc8); }
#define AT_SW(A_, B_) do { const auto r_ = __builtin_amdgcn_permlane32_swap(A_, B_, false, false); A_ = r_[0]; B_ = r_[1]; } while (0)
            AT_SW(da[0], da[1]); AT_SW(da[2], da[3]); AT_SW(da[0], da[2]); AT_SW(da[1], da[3]);
            AT_SW(db[0], db[1]); AT_SW(db[2], db[3]); AT_SW(db[0], db[2]); AT_SW(db[1], db[3]);
#undef AT_SW
            *(v4u*)op8 = (v4u){da[0], da[1], da[2], da[3]}; *(v4u*)(op8 + 32) = (v4u){db[0], db[1], db[2], db[3]}; }
        else {
        bf16* op = F.O + (size_t)qrow * D + head * 64 + 4 * hi;
#pragma unroll
        for (int rr = 0; rr < 4; ++rr) { v2u a, c; a.x = cvt_pk_bf16(o0[4 * rr] * inv, o0[4 * rr + 1] * inv); a.y = cvt_pk_bf16(o0[4 * rr + 2] * inv, o0[4 * rr + 3] * inv);
            c.x = cvt_pk_bf16(o1[4 * rr] * inv, o1[4 * rr + 1] * inv); c.y = cvt_pk_bf16(o1[4 * rr + 2] * inv, o1[4 * rr + 3] * inv);
            *(v2u*)(op + 8 * rr) = a; *(v2u*)(op + 32 + 8 * rr) = c; } }

    }
}

__device__ __forceinline__ int chain_tok(int dir, int b, int p) { return dir == 0 ? (p < LC ? T_LAT + b * LC + p : b * SEQ + (p - LC)) : (p < LC ? T_LAT + b * LC + (LC - 1 - p) : b * SEQ + (SEQ - 1 - (p - LC))); }
__device__ __forceinline__ void phase_mlstm_naive(Frame& F) {
    TIDLANE
    for (int task = blockIdx.x; task < 64; task += F.G) {
        const int cidx = task >> 1, dvh = task & 1, b = cidx >> 3, hh = (cidx >> 1) & 3, dir = cidx & 1;
        const int dv = dvh * 128 + (tid >> 2), qt = tid & 3;
        float C[32], n[32];
#pragma unroll
        for (int j = 0; j < 32; ++j) { C[j] = 0.f; n[j] = 0.f; }
        float mst = -1e30f;
#define tok(p) chain_tok(dir, b, (p))
        v4u kk[4], qq[4]; float vv, ig, fg;
        { const int m = tok(0); const bf16* row = F.QKV + (size_t)m * 3072;
#pragma unroll
          for (int i = 0; i < 4; ++i) { kk[i] = ((const v4u*)(row + 512 + hh * 128 + qt * 32))[i]; qq[i] = ((const v4u*)(row + hh * 128 + qt * 32))[i]; }
          vv = bf2f(row[1024 + hh * 256 + dv]); ig = F.GB[(size_t)m * 16 + dir * 8 + hh]; fg = F.GB[(size_t)m * 16 + dir * 8 + 4 + hh]; }
        for (int p = 0; p < LC + SEQ; ++p) {
            const int m = tok(p);
            v4u kn[4], qn[4]; float vn = 0.f, in_ = 0.f, fn = 0.f;
            if (p + 1 < LC + SEQ) { const int m2 = tok(p + 1); const bf16* row = F.QKV + (size_t)m2 * 3072;
#pragma unroll
                for (int i = 0; i < 4; ++i) { kn[i] = ((const v4u*)(row + 512 + hh * 128 + qt * 32))[i]; qn[i] = ((const v4u*)(row + hh * 128 + qt * 32))[i]; }
                vn = bf2f(row[1024 + hh * 256 + dv]); in_ = F.GB[(size_t)m2 * 16 + dir * 8 + hh]; fn = F.GB[(size_t)m2 * 16 + dir * 8 + 4 + hh]; }
            else {
#pragma unroll
                for (int i = 0; i < 4; ++i) { kn[i] = kk[i]; qn[i] = qq[i]; } }
            const float lf = fminf(fg, 0.f) - log1pf(__expf(-fabsf(fg)));
            const float mn = fmaxf(lf + mst, ig); const float fd = __expf(lf + mst - mn), iw = __expf(ig - mn); mst = mn;
            const float ivk = iw * vv * 0.08838834764831845f, iwk = iw * 0.08838834764831845f;
            float num = 0.f, den = 0.f;
#pragma unroll
            for (int i = 0; i < 4; ++i) { const unsigned kw[4] = {kk[i].x, kk[i].y, kk[i].z, kk[i].w}, qw[4] = {qq[i].x, qq[i].y, qq[i].z, qq[i].w};
#pragma unroll
                for (int j = 0; j < 4; ++j) { const int e0 = 8 * i + 2 * j; const float k0 = bflo(kw[j]), k1 = bfhi(kw[j]), q0 = bflo(qw[j]), q1 = bfhi(qw[j]);
                    C[e0] = fd * C[e0] + ivk * k0; C[e0 + 1] = fd * C[e0 + 1] + ivk * k1; n[e0] = fd * n[e0] + iwk * k0; n[e0 + 1] = fd * n[e0 + 1] + iwk * k1;
                    num += C[e0] * q0 + C[e0 + 1] * q1; den += n[e0] * q0 + n[e0 + 1] * q1; } }
            num += __shfl_xor(num, 1); num += __shfl_xor(num, 2); den += __shfl_xor(den, 1); den += __shfl_xor(den, 2);
            if (qt == 0) F.HD[((size_t)dir * T_ALL + m) * D + hh * 256 + dv] = (bf16)f2bf(num / fmaxf(fabsf(den), __expf(-mn)));
#pragma unroll
            for (int i = 0; i < 4; ++i) { kk[i] = kn[i]; qq[i] = qn[i]; }
            vv = vn; ig = in_; fg = fn;
        }
    }
#undef tok
}


constexpr int ML_QT = 0, ML_KT = 17408, ML_WK = 34816, ML_VT = 51456, ML_CI = 55616, ML_NT = 64320, ML_TA = 64832, ML_RED = 65536, ML_REDD = 98304;
constexpr float KSC = 0.08838834764831845f;

__device__ __forceinline__ v4u scale_bf16x8(v4u x, float s) {
    v4u o; o.x = cvt_pk_bf16(bflo(x.x) * s, bfhi(x.x) * s); o.y = cvt_pk_bf16(bflo(x.y) * s, bfhi(x.y) * s); o.z = cvt_pk_bf16(bflo(x.z) * s, bfhi(x.z) * s); o.w = cvt_pk_bf16(bflo(x.w) * s, bfhi(x.w) * s); return o;
}

__device__ __forceinline__ void phase_mlstm(Frame& F) {
    TIDLANE
    const int w = F.wave, r32 = lane & 31, hi = lane >> 5, g16 = lane >> 4, i16 = lane & 15;
    const int tb = w >> 2, kh = w & 1, sb = tb == 0 ? (w < 2 ? 1 : 0) : (w >= 6 ? 1 : 0), q4 = 2 * kh + sb;
    const bool st = (w & 2) == 0; const int sw = (w & 1) + 2 * (w >> 2);
    LAS unsigned char* QT = F.lds + ML_QT; LAS unsigned char* KT = F.lds + ML_KT; LAS unsigned char* WK = F.lds + ML_WK; LAS unsigned char* VT = F.lds + ML_VT; LAS unsigned char* CI = F.lds + ML_CI;
    LAS float* NT = (LAS float*)(F.lds + ML_NT); LAS float* TA = (LAS float*)(F.lds + ML_TA); LAS float* RED = (LAS float*)(F.lds + ML_RED); LAS float* REDD = (LAS float*)(F.lds + ML_REDD);
    const unsigned vr_off = (4 * (g16 >> 1) + (i16 >> 2)) * 64 + (16 * (g16 & 1) + 4 * (i16 & 3)) * 2;
    const int stok = tid >> 3, sdk = 8 * (tid & 7);
    const int vtok = tid >> 2, vpc = tid & 3;
    constexpr int NCH = (LC + SEQ) / 64;
    for (int task = F.vcu; task < 256; task += F.G) {
        const int cidx = task >> 3, ds = task & 7, b = cidx >> 3, hh = (cidx >> 1) & 3, dir = cidx & 1;
        f32x16 accC;
#pragma unroll
        for (int r = 0; r < 16; ++r) accC[r] = 0.f;
        float m_c = -1e30f; f32x16 nacc;
#pragma unroll
        for (int r = 0; r < 16; ++r) nacc[r] = 0.f;
        __syncthreads();
        for (int i = tid; i < (8704 + 512) / 4; i += NTHREADS) ((LAS unsigned*)CI)[i] = 0u;
        v4u qreg[2], kreg[2], vreg = {0u, 0u, 0u, 0u}; float gi, gf;
#define CH_BASE(c) __builtin_amdgcn_readfirstlane(dir == 0 ? ((c) < 4 ? T_LAT + b * LC + 64 * (c) : b * SEQ + 64 * ((c) - 4)) : ((c) < 4 ? T_LAT + b * LC + (LC - 1) - 64 * (c) : b * SEQ + (SEQ - 1) - 64 * ((c) - 4)))
#define CH_TOK(cb, pos) (dir == 0 ? (cb) + (pos) : (cb) - (pos))
#define ML_LOAD(c) do { const int cb_ = CH_BASE(c); const int m_ = CH_TOK(cb_, stok); const bf16* row_ = F.QKV + (size_t)m_ * 3072; \
            qreg[0] = *(const v4u*)(row_ + hh * 128 + sdk); qreg[1] = *(const v4u*)(row_ + hh * 128 + 64 + sdk); kreg[0] = *(const v4u*)(row_ + 512 + hh * 128 + sdk); kreg[1] = *(const v4u*)(row_ + 512 + hh * 128 + 64 + sdk); \
            if (tid < 256) { const int mv_ = CH_TOK(cb_, vtok); vreg = *(const v4u*)(F.QKV + (size_t)mv_ * 3072 + 1024 + hh * 256 + ds * 32 + 8 * vpc); } \
            const int mg_ = CH_TOK(cb_, lane); gi = F.GB[(size_t)mg_ * 16 + dir * 8 + hh]; gf = F.GB[(size_t)mg_ * 16 + dir * 8 + 4 + hh]; } while (0)
        ML_LOAD(0);
        for (int c = 0; c < NCH; ++c) {
            const float lf = fminf(gf, 0.f) - __logf(1.f + __expf(-fabsf(gf)));
            const float bc = wave_scan_add(lf);
            const float av = gi - bc; const float pm = wave_scan_max(av);
            const float Bc = __builtin_bit_cast(float, __builtin_amdgcn_readlane(__builtin_bit_cast(int, bc), 63)), amax = __builtin_bit_cast(float, __builtin_amdgcn_readlane(__builtin_bit_cast(int, pm), 63));
            const float mnext = Bc + fmaxf(m_c, amax), gg = fmaxf(pm, m_c);
            const float wgt = __expf(av + Bc - mnext) * KSC, nmv = -(bc + gg), inter = __expf(m_c - gg), decay = __expf(Bc + m_c - mnext);
            { const float wst = __shfl(wgt, 8 * w + (lane >> 3));
              *(LAS v4u*)(QT + stok * 272 + sdk * 2) = qreg[0]; *(LAS v4u*)(QT + stok * 272 + 128 + sdk * 2) = qreg[1];
              *(LAS v4u*)(KT + stok * 272 + sdk * 2) = kreg[0]; *(LAS v4u*)(KT + stok * 272 + 128 + sdk * 2) = kreg[1];
              *(LAS v4u*)(WK + (sdk >> 5) * AT_VD + stok * 64 + (sdk & 31) * 2) = scale_bf16x8(kreg[0], wst);
              *(LAS v4u*)(WK + (2 + (sdk >> 5)) * AT_VD + stok * 64 + (sdk & 31) * 2) = scale_bf16x8(kreg[1], wst);
              if (tid < 256) *(LAS v4u*)(VT + vtok * 64 + vpc * 16) = vreg;
              if (w == 0) TA[lane] = av * LOG2E; }
            const float nm_out = __shfl(nmv, 8 * w + (lane >> 3));
            __syncthreads();
            const float gTl = __shfl(gg, 32 * tb + r32) * LOG2E + 3.5f, interT = __shfl(inter, 32 * tb + r32);
            bf16x8 qf[4], kfr[4], qa[2], cfr[2]; f32x4 nt0[2], nt1[2]; s16x4 pv0[2], pv1[2];
#pragma unroll
            for (int k = 0; k < 4; ++k) { qf[k] = *(const LAS bf16x8*)(QT + (32 * tb + r32) * 272 + (64 * kh + 16 * k + 8 * hi) * 2); kfr[k] = *(const LAS bf16x8*)(KT + (32 * sb + r32) * 272 + (64 * kh + 16 * k + 8 * hi) * 2); }
#pragma unroll
            for (int k = 0; k < 2; ++k) { qa[k] = *(const LAS bf16x8*)(QT + (32 * tb + r32) * 272 + (32 * q4 + 16 * k + 8 * hi) * 2); cfr[k] = *(const LAS bf16x8*)(CI + r32 * 272 + (32 * q4 + 16 * k + 8 * hi) * 2); }
#pragma unroll
            for (int s = 0; s < 2; ++s) { pv0[s] = ds_tr(VT + vr_off + (2 * sb + s) * 1024); pv1[s] = ds_tr(VT + vr_off + (2 * sb + s) * 1024 + 512); }
            __builtin_amdgcn_sched_barrier(0);
            f32x16 sacc, apv, ain;
#pragma unroll
            for (int r = 0; r < 16; ++r) { sacc[r] = 0.f; apv[r] = 0.f; ain[r] = 0.f; }
            f32x16 Ua, Un;
#pragma unroll
            for (int r = 0; r < 16; ++r) { Ua[r] = 0.f; Un[r] = 0.f; }
            if (st) { const bf16x8 ones = (bf16x8){0x3F80, 0x3F80, 0x3F80, 0x3F80, 0x3F80, 0x3F80, 0x3F80, 0x3F80}; s16x4 wk0[4], wk1[4], vt0[4], vt1[4];
#pragma unroll
                for (int s = 0; s < 4; ++s) { wk0[s] = ds_tr(WK + sw * AT_VD + vr_off + s * 1024); wk1[s] = ds_tr(WK + sw * AT_VD + vr_off + s * 1024 + 512); vt0[s] = ds_tr(VT + vr_off + s * 1024); vt1[s] = ds_tr(VT + vr_off + s * 1024 + 512); }
#pragma unroll
                for (int s = 0; s < 4; ++s) { const s16x4 a0 = wk0[s], a1 = wk1[s], b0 = vt0[s], b1 = vt1[s];
                    const bf16x8 af = (bf16x8){a0[0], a0[1], a0[2], a0[3], a1[0], a1[1], a1[2], a1[3]}, bfr = (bf16x8){b0[0], b0[1], b0[2], b0[3], b1[0], b1[1], b1[2], b1[3]};
                    Ua = __builtin_amdgcn_mfma_f32_32x32x16_bf16(af, bfr, Ua, 0, 0, 0);
                    Un = __builtin_amdgcn_mfma_f32_32x32x16_bf16(af, ones, Un, 0, 0, 0); } }
#pragma unroll
            for (int k = 0; k < 2; ++k) ain = __builtin_amdgcn_mfma_f32_32x32x16_bf16(cfr[k], qa[k], ain, 0, 0, 0);
#pragma unroll
            for (int k = 0; k < 2; ++k) { nt0[k] = *(const LAS f32x4*)(NT + 32 * q4 + 16 * k + 8 * hi); nt1[k] = *(const LAS f32x4*)(NT + 32 * q4 + 16 * k + 8 * hi + 4); }
            float den_in = 0.f;
#pragma unroll
            for (int k = 0; k < 2; ++k) { const v4u qw = __builtin_bit_cast(v4u, qa[k]); const f32x4 n0 = nt0[k], n1 = nt1[k];
                den_in += n0[0] * bflo(qw.x) + n0[1] * bfhi(qw.x) + n0[2] * bflo(qw.y) + n0[3] * bfhi(qw.y) + n1[0] * bflo(qw.z) + n1[1] * bfhi(qw.z) + n1[2] * bflo(qw.w) + n1[3] * bfhi(qw.w); }
            den_in += __shfl_xor(den_in, 32);
            float den_s = 0.f;
            if (sb <= tb) {
#pragma unroll
                for (int k = 0; k < 4; ++k) sacc = __builtin_amdgcn_mfma_f32_32x32x16_bf16(kfr[k], qf[k], sacc, 0, 0, 0);
                f32x4 ta4[4];
#pragma unroll
                for (int rr = 0; rr < 4; ++rr) ta4[rr] = *(const LAS f32x4*)(TA + 32 * sb + 8 * rr + 4 * hi);
                if (sb == tb) {
#pragma unroll
                    for (int rr = 0; rr < 4; ++rr) { const f32x4 a4 = ta4[rr];
#pragma unroll
                        for (int j = 0; j < 4; ++j) { const int sp = 8 * rr + 4 * hi + j; const float dm = __builtin_amdgcn_exp2f(a4[j] - gTl);
                            const float p = (sp <= r32) ? sacc[4 * rr + j] * dm : 0.f; sacc[4 * rr + j] = p; den_s += p; } }
                } else {
#pragma unroll
                    for (int rr = 0; rr < 4; ++rr) { const f32x4 a4 = ta4[rr];
#pragma unroll
                        for (int j = 0; j < 4; ++j) { const float p = sacc[4 * rr + j] * __builtin_amdgcn_exp2f(a4[j] - gTl); sacc[4 * rr + j] = p; den_s += p; } }
                }
                den_s += __shfl_xor(den_s, 32);
                bf16x8 pf[2];
#pragma unroll
                for (int s = 0; s < 2; ++s) { const int rb = 8 * s;
                    v4u pk; pk.x = cvt_pk_bf16(sacc[rb], sacc[rb + 1]); pk.y = cvt_pk_bf16(sacc[rb + 2], sacc[rb + 3]); pk.z = cvt_pk_bf16(sacc[rb + 4], sacc[rb + 5]); pk.w = cvt_pk_bf16(sacc[rb + 6], sacc[rb + 7]);
                    pf[s] = __builtin_bit_cast(bf16x8, pk); }
#pragma unroll
                for (int s = 0; s < 2; ++s) { const s16x4 a0 = pv0[s], a1 = pv1[s];
                    const bf16x8 vf = (bf16x8){a0[0], a0[1], a0[2], a0[3], a1[0], a1[1], a1[2], a1[3]};
                    apv = __builtin_amdgcn_mfma_f32_32x32x16_bf16(vf, pf[s], apv, 0, 0, 0); }
            }
            if (c + 1 < NCH) ML_LOAD(c + 1);
            { LAS f32x4* rp = (LAS f32x4*)(RED + (w * 64 + lane) * 16);
#pragma unroll
              for (int rr = 0; rr < 4; ++rr) { f32x4 v; v[0] = apv[4 * rr] + interT * ain[4 * rr]; v[1] = apv[4 * rr + 1] + interT * ain[4 * rr + 1]; v[2] = apv[4 * rr + 2] + interT * ain[4 * rr + 2]; v[3] = apv[4 * rr + 3] + interT * ain[4 * rr + 3]; rp[rr] = v; }
              if (hi == 0) REDD[w * 32 + r32] = den_s + interT * den_in; }
            if (st) {
#pragma unroll
                for (int r = 0; r < 16; ++r) { accC[r] = __builtin_fmaf(decay, accC[r], Ua[r]); nacc[r] = __builtin_fmaf(decay, nacc[r], Un[r]); } }
            __syncthreads();
            if (st) {
#pragma unroll
                for (int rr = 0; rr < 4; ++rr) { v2u o; o.x = cvt_pk_bf16(accC[4 * rr], accC[4 * rr + 1]); o.y = cvt_pk_bf16(accC[4 * rr + 2], accC[4 * rr + 3]); *(LAS v2u*)(CI + r32 * 272 + (32 * sw + 8 * rr + 4 * hi) * 2) = o; } }
            if (st && r32 == 0) {
#pragma unroll
                for (int rr = 0; rr < 4; ++rr) *(LAS f32x4*)(NT + 32 * sw + 8 * rr + 4 * hi) = (f32x4){nacc[4 * rr], nacc[4 * rr + 1], nacc[4 * rr + 2], nacc[4 * rr + 3]}; }
            { const int t = tid >> 3, q = tid & 7, tbo = t >> 5, lo = (t & 31) + 32 * (q & 1);
              f32x4 num = {0.f, 0.f, 0.f, 0.f}; float den = 0.f;
#pragma unroll
              for (int k4 = 0; k4 < 4; ++k4) { const int wv = 4 * tbo + k4; num = num + *(const LAS f32x4*)(RED + (wv * 64 + lo) * 16 + 4 * (q >> 1)); den += REDD[wv * 32 + (t & 31)]; }
              const float dd = 1.f / fmaxf(fabsf(den), __expf(nm_out));
              const int mo = CH_TOK(CH_BASE(c), t);
              const f32x4 hv = num * dd; v2u hw; hw.x = cvt_pk_bf16(hv[0], hv[1]); hw.y = cvt_pk_bf16(hv[2], hv[3]);
              *(v2u*)(F.HD + ((size_t)dir * T_ALL + mo) * D + hh * 256 + ds * 32 + 4 * q) = hw; }
            m_c = mnext;
        }
#undef ML_LOAD
#undef CH_TOK
#undef CH_BASE
    }
}

__device__ __forceinline__ void phase_mlstm_readout(Frame& F) {
    TIDLANE
    const float* hn = F.in[I_MHN];
    f32x4 g[4];
#pragma unroll
    for (int j = 0; j < 4; ++j) g[j] = ((const f32x4*)hn)[lane + 64 * j];
    for (int m = F.gw; m < T_ALL; m += F.NGW) {
        v2u a[4], b2[4], ow[4];
#pragma unroll
        for (int j = 0; j < 4; ++j) { a[j] = ((const v2u*)(F.HD + (size_t)m * D))[lane + 64 * j]; b2[j] = ((const v2u*)(F.HD + ((size_t)T_ALL + m) * D))[lane + 64 * j]; ow[j] = ((const v2u*)(F.QKV + (size_t)m * 3072 + 2048))[lane + 64 * j]; }
        __builtin_amdgcn_sched_barrier(0);
#pragma unroll
        for (int j = 0; j < 4; ++j) {
            const f32x4 v = {bflo(a[j].x) + bflo(b2[j].x), bfhi(a[j].x) + bfhi(b2[j].x), bflo(a[j].y) + bflo(b2[j].y), bfhi(a[j].y) + bfhi(b2[j].y)}; const float ss = wave_sum((v[0] * v[0] + v[1] * v[1]) + (v[2] * v[2] + v[3] * v[3]));
            const float r = 1.f / sqrtf(ss * (1.f / 256.f) + EPS);
            const float o0 = v[0] * r * g[j][0] * sigmoidf_(bflo(ow[j].x)), o1 = v[1] * r * g[j][1] * sigmoidf_(bfhi(ow[j].x)), o2 = v[2] * r * g[j][2] * sigmoidf_(bflo(ow[j].y)), o3 = v[3] * r * g[j][3] * sigmoidf_(bfhi(ow[j].y));
            if (WO_F8) ((unsigned*)((unsigned char*)F.O + (size_t)m * D))[lane + 64 * j] = pack4_fp8(o0 * F8_DS, o1 * F8_DS, o2 * F8_DS, o3 * F8_DS);
            else { v2u w; w.x = pk2(o0, o1); w.y = pk2(o2, o3); ((v2u*)(F.O + (size_t)m * D))[lane + 64 * j] = w; }
        }
    }
}

__device__ __forceinline__ void phase_final(Frame& F, float* out, int combine_layer) {
    TIDLANE
    const float* fg = F.in[I_FG]; f32x4 fgv[4];
#pragma unroll
    for (int j = 0; j < 4; ++j) fgv[j] = ((const f32x4*)fg)[lane + 64 * j];
    for (int m = F.gw; m < T_LAT; m += F.NGW) {
        f32x4 v[4]; float ss = 0.f;
#if YS_F8
        v2u xr[4]; int yr[4][4]; f32x4 g5r[4];
        { const float* g5 = F.mod + (size_t)((combine_layer >= 0 ? combine_layer : 0) * 5 + m / SEQ) * 6144 + 5 * D;
#pragma unroll
          for (int j = 0; j < 4; ++j) { xr[j] = *(const v2u*)(F.X + (size_t)m * D + 4 * (lane + 64 * j)); g5r[j] = ((const f32x4*)g5)[lane + 64 * j];
#pragma unroll
              for (int k = 0; k < 4; ++k) yr[j][k] = combine_layer >= 0 ? ((const int*)((const unsigned char*)F.YS + (size_t)(m * 4 + k) * D))[lane + 64 * j] : 0; } }
        __builtin_amdgcn_sched_barrier(0);
#endif
#pragma unroll
        for (int j = 0; j < 4; ++j) {
#if YS_F8
            v[j] = (f32x4){bflo(xr[j].x), bfhi(xr[j].x), bflo(xr[j].y), bfhi(xr[j].y)};
#else
            v[j] = ld4bf(F.X + (size_t)m * D + 4 * (lane + 64 * j));
#endif
            if (combine_layer >= 0) { const float* g5 = F.mod + (size_t)(combine_layer * 5 + m / SEQ) * 6144 + 5 * D; f32x4 y = {0.f, 0.f, 0.f, 0.f};
#pragma unroll
                for (int k = 0; k < 4; ++k) {
#if YS_F8
                    const int w = yr[j][k];
                    y[0] += __builtin_amdgcn_cvt_f32_fp8(w, 0) * (1.f / F8_YS); y[1] += __builtin_amdgcn_cvt_f32_fp8(w, 1) * (1.f / F8_YS); y[2] += __builtin_amdgcn_cvt_f32_fp8(w, 2) * (1.f / F8_YS); y[3] += __builtin_amdgcn_cvt_f32_fp8(w, 3) * (1.f / F8_YS);
#else
                    const v2u w = ((const v2u*)(F.YS + (size_t)(m * 4 + k) * D))[lane + 64 * j]; y[0] += bflo(w.x); y[1] += bfhi(w.x); y[2] += bflo(w.y); y[3] += bfhi(w.y);
#endif
                }
#if YS_F8
                (void)g5; v[j] = v[j] + g5r[j] * y; }
#else
                v[j] = v[j] + ((const f32x4*)g5)[lane + 64 * j] * y; }
#endif
            ss += (v[j][0] * v[j][0] + v[j][1] * v[j][1]) + (v[j][2] * v[j][2] + v[j][3] * v[j][3]); }
        const float r = 1.f / sqrtf(wave_sum(ss) * (1.f / D) + EPS);
#pragma unroll
        for (int j = 0; j < 4; ++j) ((f32x4*)(out + (size_t)m * D))[lane + 64 * j] = v[j] * r * fgv[j];
    }
}

constexpr int NPH = 31;
#ifndef PROBE_MASK
#define PROBE_MASK 0ull
#endif
#ifndef PROBE_N
#define PROBE_N 3
#endif
#ifndef MLSTM_MFMA
#define MLSTM_MFMA 1
#endif
#if MLSTM_MFMA
#define MLSTM_CALL() phase_mlstm(F)
#else
#define MLSTM_CALL() phase_mlstm_naive(F)
#endif
#ifndef ATTN_MFMA
#define ATTN_MFMA 1
#endif
#if ATTN_MFMA
#define ATTN_CALL(M, a, b, wc) phase_attn<M>(F, a, b, wc)
#else
#define ATTN_CALL(M, a, b, wc) phase_attn_naive<M>(F, a, b)
#endif

__global__ void __launch_bounds__(NTHREADS, 2) fwd(Args args) {
    extern __shared__ __attribute__((aligned(16))) unsigned char lds_raw[];
    Frame F;
    F.lds = (LAS unsigned char*)lds_raw;
    F.MISC = (volatile LAS unsigned*)(F.lds + MISC_OFF);
    F.wave = __builtin_amdgcn_readfirstlane(threadIdx.x >> 6);
    F.G = gridDim.x; { const int bx = blockIdx.x; F.vcu = (F.G % 8 == 0) ? (bx % 8) * (F.G / 8) + bx / 8 : bx; }
    F.gw = blockIdx.x * NWAVES + F.wave; F.NGW = F.G * NWAVES;
#pragma unroll
    for (int i = 0; i < 25; ++i) F.in[i] = args.in[i];
    F.ws = args.ws; unsigned char* ws = args.ws;
    F.ctl = (unsigned*)(ws + WS_CTL);
    F.mod = (float*)(ws + WS_MOD); F.X = (bf16*)(ws + WS_X); F.H = (bf16*)(ws + WS_H); F.QKV = (bf16*)(ws + WS_QKV); F.O = (bf16*)(ws + WS_O);
    F.ACT = (bf16*)(ws + WS_ACT); F.YS = (bf16*)(ws + WS_YS); F.slot_of = (int*)(ws + WS_SLOT); F.gate_of = (float*)(ws + WS_GATE); F.GB = (float*)(ws + WS_GB); F.HD = (bf16*)(ws + WS_HD);
    for (int u = threadIdx.x; u < (LDS_BYTES - MISC_OFF) / 4; u += NTHREADS) ((LAS unsigned*)(F.lds + MISC_OFF))[u] = 0u;
    __syncthreads();
    XcdBarrier bar = xcd_barrier_post(F.ctl + CW_BAR, F.MISC + 8);
    const int lo = args.ph_lo, hi = args.ph_hi;
#define IN(k) (lo <= (k) && (k) < hi)
#define SEAM(k) do { if (IN(k) && IN((k) + 1)) xcd_barrier(bar, F.wave); } while (0)
#define NREP(k) ((((unsigned long long)(PROBE_MASK) >> (k)) & 1ull) ? (PROBE_N) : 1)
#define PH(k, ...) do { if (IN(k)) { { const int rep_ = 0; (void)rep_; __VA_ARGS__ } if (NREP(k) >= 2) { const int rep_ = 1; (void)rep_; __VA_ARGS__ } if (NREP(k) >= 3) { const int rep_ = 2; (void)rep_; __VA_ARGS__ } } SEAM(k); } while (0)
#define DENSE_A(f8) ((f8) ? (const void*)(ws + WS_H8) : (const void*)F.H)
#define DENSE_GEMM(EPI, EOBJ, f8, Btptr, N_) DENSE_GEMM_M(EPI, EOBJ, DENSE_A(f8), Btptr, N_, T_ALL / 256, f8)
#define DENSE_GEMM_M(EPI, EOBJ, Aptr, Btptr, N_, NM_, F8_) do { pg8::DenseOrder S_; S_.nN = (N_) / 256; S_.nunits = (NM_) * S_.nN; S_.G = F.G; S_.c = F.vcu; S_.Bt = (const char*)(Btptr); S_.tstep = (size_t)256 * D * ((F8_) ? 1 : 2); \
        pg8::gemm_phase<EPI, pg8::DenseOrder, (F8_) != 0>(F.lds, (const char*)(Aptr), D, S_, EOBJ, F.wave); } while (0)
#define MOE_PHASES(l, p0) do { \
    PH(p0, phase_pre2(F, l, rep_ == 0, (l) == 3 ? T_LAT : T_ALL);); \
    PH((p0) + 1, moe_tables(F, l); pg8::MoeOrder<true> S_; S_.nN = 8; S_.G = F.G; S_.c = F.vcu; S_.Bt = (const char*)(ws + WS_EWIN) + (size_t)(l) * 32 * 2048 * D; S_.tstep = (size_t)256 * D; S_.estep = (size_t)2048 * D; \
        S_.tstart = (const LAS int*)(F.lds + MISC_OFF + 64); S_.cnt = (const LAS int*)(F.lds + MISC_OFF + 256); S_.slot_of = F.slot_of; \
        pg8::EpiSwiglu E_{(unsigned char*)F.ACT, F.in[I_EBIN] + (size_t)(l) * 32 * 2048, F.slot_of}; pg8::gemm_phase<pg8::EpiSwiglu, pg8::MoeOrder<true>, true>(F.lds, (const char*)(ws + WS_H8), D, S_, E_, F.wave); ); \
    PH((p0) + 2, if (!IN((p0) + 1)) moe_tables(F, l);   pg8::MoeOrder<false> S_; S_.nN = 4; S_.G = F.G; S_.c = F.vcu; S_.Bt = (const char*)(ws + WS_EWOUT) + (size_t)(l) * 32 * D * DFF; S_.tstep = (size_t)256 * DFF; S_.estep = (size_t)D * DFF; \
        S_.tstart = (const LAS int*)(F.lds + MISC_OFF + 64); S_.cnt = (const LAS int*)(F.lds + MISC_OFF + 256); S_.slot_of = F.slot_of; \
        pg8::EpiMoe2 E_{F.YS, F.in[I_EBOUT] + (size_t)(l) * 32 * D, F.slot_of, F.gate_of}; pg8::gemm_phase<pg8::EpiMoe2, pg8::MoeOrder<false>, true>(F.lds, (const char*)F.ACT, DFF, S_, E_, F.wave); ); } while (0)
#define WO_PHASE(l, p, Wt) PH(p, pg8::EpiRes E_{F.X, F.mod + (size_t)((l) * 5) * 6144 + 2 * D, rep_ == 0 ? 1.f : 0.f}; DENSE_GEMM_M(pg8::EpiRes, E_, F.O, Wt, 1024, (l) == 3 ? T_LAT / 256 : T_ALL / 256, WO_F8);)

    PH(0, phase_setup(F););
    PH(1, phase_pre1<true, false>(F, 0, 1.f););
    PH(2, pg8::EpiQkvA E_{F.QKV}; DENSE_GEMM(pg8::EpiQkvA, E_, QKV_F8_A, ws + WS_AWQKV, 1536););
    PH(3, ATTN_CALL(0, F.in[I_ASINK], nullptr, true););
    WO_PHASE(0, 4, ws + WS_AWO);
    MOE_PHASES(0, 5);
    PH(8, phase_pre1<false, true>(F, 1, rep_ == 0 ? 1.f : 0.f););
    PH(9, pg8::EpiBf16 E_{F.QKV, 3072}; DENSE_GEMM(pg8::EpiBf16, E_, QKV_F8_M, ws + WS_MWIN, 3072););
    PH(10, MLSTM_CALL(););
    PH(11, phase_mlstm_readout(F););
    WO_PHASE(1, 12, ws + WS_MWO);
    MOE_PHASES(1, 13);
    PH(16, phase_pre1<false, false>(F, 2, rep_ == 0 ? 1.f : 0.f););
    PH(17, pg8::EpiBf16 E_{F.QKV, 3072}; DENSE_GEMM(pg8::EpiBf16, E_, QKV_F8_N, ws + WS_NWQKV, 3072););
    PH(18, ATTN_CALL(1, nullptr, F.in[I_NRPB], true););
    WO_PHASE(2, 19, ws + WS_NWO);
    MOE_PHASES(2, 20);
    PH(23, phase_pre1<false, false>(F, 3, rep_ == 0 ? 1.f : 0.f););
    PH(24, pg8::EpiQkvA E_{F.QKV}; DENSE_GEMM(pg8::EpiQkvA, E_, QKV_F8_A, ws + WS_AWQKV + (size_t)1536 * D * (QKV_F8_A ? 1 : 2), 1536););
    PH(25, ATTN_CALL(0, F.in[I_ASINK] + 16, nullptr, false););
    WO_PHASE(3, 26, ws + WS_AWO + (size_t)D * D * (WO_F8 ? 1 : 2));
    MOE_PHASES(3, 27);
    PH(30, phase_final(F, args.out, args.fin_combine););
#undef IN
#undef SEAM
}

#ifndef MK_PER_PHASE
#define MK_PER_PHASE 0
#endif
#ifndef MK_STOP
#define MK_STOP 30
#endif

extern "C" void kernel_launch(void* const* d_in, const int* in_sizes, int n_in, void* d_out, int out_size, void* d_ws, size_t ws_size, hipStream_t stream) {
    static int grid = 0;
    if (grid == 0) {
        if (n_in != 25 || out_size != T_LAT * D || ws_size < WS_END) { fprintf(stderr, "kernel_launch: unexpected shapes n_in %d out %d ws %zu (need %zu)\n", n_in, out_size, ws_size, (size_t)WS_END); grid = -1; return; }
        int dev = 0, cus = 0, per_cu = 0;
        (void)hipGetDevice(&dev); (void)hipDeviceGetAttribute(&cus, hipDeviceAttributeMultiprocessorCount, dev);
        (void)hipFuncSetAttribute((const void*)fwd, hipFuncAttributeMaxDynamicSharedMemorySize, LDS_BYTES);
        (void)hipOccupancyMaxActiveBlocksPerMultiprocessor(&per_cu, (const void*)fwd, NTHREADS, LDS_BYTES);
        (void)hipGetLastError();
        grid = cus;
        fprintf(stderr, "kernel_launch: grid %d, occupancy query %d, ws %zu\n", grid, per_cu, ws_size);
    }
    if (grid < 0) return;
    (void)hipMemsetAsync((char*)d_ws + WS_CTL, 0, CTL_BYTES, stream);
    Args a{};
    for (int i = 0; i < 25; ++i) a.in[i] = (const float*)d_in[i];
    a.out = (float*)d_out; a.ws = (unsigned char*)d_ws; a.stop_layers = 0;
    a.fin_combine = MK_STOP >= 30 ? 3 : MK_STOP == 23 ? 2 : MK_STOP == 16 ? 1 : MK_STOP == 8 ? 0 : -1;
#if MK_PER_PHASE
    for (int p = 0; p < NPH; ++p) { if (p >= MK_STOP && p != 30) continue; a.ph_lo = p; a.ph_hi = p + 1; hipLaunchKernelGGL(fwd, dim3(grid), dim3(NTHREADS), LDS_BYTES, stream, a); }
#else
    a.ph_lo = 0; a.ph_hi = NPH; hipLaunchKernelGGL(fwd, dim3(grid), dim3(NTHREADS), LDS_BYTES, stream, a);
#endif
}
```
